# Optimizing an MI355X kernel written in HIP

```python
import math
import jax
import jax.numpy as jnp
from jax import lax
import numpy as np

D_MODEL = 1024
BATCH = 16
SEQ = 2048
DEPTH = 2

CTX_LEN = 256
GRID_W = 64
N_MIXERS = 4
GROUP_W = D_MODEL // N_MIXERS
MIX_W = N_MIXERS * GROUP_W
EPS = 1e-6
F32 = jnp.float32

HG_HEADS = 4
HG_DK = GROUP_W // HG_HEADS
HG_DV = GROUP_W // HG_HEADS
HG_CHUNK = 16
S5_CH = 16
S5_GROUPS = GROUP_W // S5_CH
S5_STATE = 64
DT_MIN = 1e-3
DT_MAX = 1e-1
DA_HEADS = 4
DA_DQK = GROUP_W // (2 * DA_HEADS)
DA_DV = GROUP_W // DA_HEADS
Q_BLOCK = 128
ROPE_BASE = 10000.0
ML_HEADS = 4
ML_DK = GROUP_W // ML_HEADS
ML_DV = GROUP_W // ML_HEADS
ML_CHUNK = 64
N_EXPERTS = 16
EC_CAPACITY = 2
D_EXPERT = 2 * D_MODEL

HG_OFF = 0
S5_OFF = HG_OFF + 5 * GROUP_W
DA_OFF = S5_OFF + GROUP_W
ML_OFF = DA_OFF + 3 * GROUP_W
ML_GATE_OFF = ML_OFF + 4 * GROUP_W
IN_COLS = ML_GATE_OFF + 4 * ML_HEADS

kernel_name = 'hybrid_diffusion_parallel_groups_ecmoe'


def rms_norm(x, w):
    xf = x.astype(F32)
    y = xf * lax.rsqrt(jnp.mean(xf * xf, axis=-1, keepdims=True) + EPS)
    return (y * w.astype(F32)).astype(x.dtype)


def head_rms_norm(x, w, n_heads):
    shp = x.shape
    xh = x.reshape(shp[:-1] + (n_heads, -1))
    return rms_norm(xh, w.reshape(n_heads, -1)).reshape(shp)


def modulated(h, norm_w, shift, scale):
    return rms_norm(h, norm_w) * (1.0 + scale) + shift


def flip_seq(a, reverse):
    return a[:, ::-1] if reverse else a


def rope_2d(n, dim):
    axis_dim = dim // 2
    inv = ROPE_BASE ** (-jnp.arange(0, axis_dim, 2, dtype=F32) / axis_dim)
    t = jnp.arange(n, dtype=jnp.int32)
    row = (t // GRID_W).astype(F32)
    col = (t % GRID_W).astype(F32)
    ang = jnp.concatenate([row[:, None] * inv, col[:, None] * inv], axis=-1)
    return jnp.cos(ang), jnp.sin(ang)


def apply_rope(x, cos, sin):
    xr = x.astype(F32).reshape(x.shape[:-1] + (-1, 2))
    x1, x2 = xr[..., 0], xr[..., 1]
    shp = (1, cos.shape[0]) + (1,) * (x.ndim - 3) + (cos.shape[1],)
    c, s = cos.reshape(shp), sin.reshape(shp)
    y = jnp.stack([x1 * c - x2 * s, x1 * s + x2 * c], axis=-1)
    return y.reshape(x.shape).astype(x.dtype)


def gla_chunked(q, k, v, log_f, s0, with_out=True):
    bsz, t_len, nh, _ = q.shape
    nc = t_len // HG_CHUNK
    def chunks(a):
        return a.astype(F32).reshape(bsz, nc, HG_CHUNK, nh, a.shape[-1])
    q, k, v, log_f = chunks(q), chunks(k), chunks(v), chunks(log_f)
    b = jnp.cumsum(log_f, axis=2)
    b_end = b[:, :, -1]
    ds = jnp.einsum('bcshd,bcshv->bchdv', k * jnp.exp(b_end[:, :, None] - b), v)
    def step(s, inp):
        g_c, ds_c = inp
        return jnp.exp(g_c)[..., None] * s + ds_c, s
    s_fin, s_start = lax.scan(step, s0, (jnp.moveaxis(b_end, 1, 0), jnp.moveaxis(ds, 1, 0)))
    if not with_out:
        return None, s_fin
    s_start = jnp.moveaxis(s_start, 0, 1)
    tri = jnp.tril(jnp.ones((HG_CHUNK, HG_CHUNK), bool))[None, None, :, :, None, None]
    decay = jnp.exp(jnp.where(tri, b[:, :, :, None] - b[:, :, None], -jnp.inf))
    scores = jnp.sum(q[:, :, :, None] * decay * k[:, :, None], axis=-1)
    o = (jnp.einsum('bctsh,bcshv->bcthv', scores, v)
         + jnp.einsum('bcthd,bchdv->bcthv', q * jnp.exp(b), s_start))
    return o.reshape(bsz, t_len, nh, -1), s_fin


def hgrn2_mixer(zc, zl, lb, norm_w, with_ctx_out):
    def heads(a):
        return a.reshape(a.shape[:2] + (HG_HEADS, -1))
    def split(z):
        q, i, ff, fb, g = jnp.split(z, 5, axis=-1)
        return heads(q) * HG_DK ** -0.5, heads(i), (heads(ff), heads(fb)), g
    qc, ic, fc, gc = split(zc)
    ql, il, fl, gl = split(zl)
    oc, ol = 0.0, 0.0
    for d in range(2):
        lbd = lb[d].reshape(HG_HEADS, HG_DK)
        f_c = lbd + (1.0 - lbd) * jax.nn.sigmoid(fc[d].astype(F32))
        f_l = lbd + (1.0 - lbd) * jax.nn.sigmoid(fl[d].astype(F32))
        s0 = jnp.zeros((zc.shape[0], HG_HEADS, HG_DK, HG_DV), F32)
        o_c, s_c = gla_chunked(flip_seq(qc, d), flip_seq(1.0 - f_c, d), flip_seq(ic, d),
                               flip_seq(jnp.log(f_c), d), s0, with_ctx_out)
        o_l, _ = gla_chunked(flip_seq(ql, d), flip_seq(1.0 - f_l, d), flip_seq(il, d),
                             flip_seq(jnp.log(f_l), d), s_c)
        ol = ol + flip_seq(o_l, d)
        if with_ctx_out:
            oc = oc + flip_seq(o_c, d)
    def readout(o, g):
        o = o.reshape(o.shape[:2] + (-1,)).astype(g.dtype)
        return head_rms_norm(o, norm_w, HG_HEADS) * jax.nn.silu(g)
    return (readout(oc, gc) if with_ctx_out else None), readout(ol, gl)


def cmul(ar, ai, br, bi):
    return ar * br - ai * bi, ar * bi + ai * br


def s5_combine(e1, e2):
    a1r, a1i, x1r, x1i = e1
    a2r, a2i, x2r, x2i = e2
    ar, ai = cmul(a2r, a2i, a1r, a1i)
    yr, yi = cmul(a2r, a2i, x1r, x1i)
    return ar, ai, yr + x2r, yi + x2i


def s5_mixer(uc, ul, lam_re, lam_im, log_dt, b_re, b_im, c_re, c_im, d_skip, glu_w, glu_b, with_ctx_out):
    def groups(u):
        return u.astype(F32).reshape(u.shape[:2] + (S5_GROUPS, S5_CH))
    gc, gl = groups(uc), groups(ul)
    b_re, b_im, c_re, c_im = (a.astype(F32) for a in (b_re, b_im, c_re, c_im))
    def b_proj(u):
        return jnp.einsum('bngc,gpc->bngp', u, b_re), jnp.einsum('bngc,gpc->bngp', u, b_im)
    def c_read(xr, xi):
        return jnp.einsum('bngp,gcp->bngc', xr, c_re) - jnp.einsum('bngp,gcp->bngc', xi, c_im)
    buc, bul = b_proj(gc), b_proj(gl)
    yc, yl = 0.0, 0.0
    for d in range(2):
        lr, li = lam_re[d].astype(F32), lam_im[d].astype(F32)
        dt = jnp.exp(log_dt[d].astype(F32))[:, None]
        mag = jnp.exp(lr * dt)
        ab_re, ab_im = mag * jnp.cos(li * dt), mag * jnp.sin(li * dt)
        den = lr * lr + li * li
        co_re = ((ab_re - 1.0) * lr + ab_im * li) / den
        co_im = (ab_im * lr - (ab_re - 1.0) * li) / den
        def run(bu, x0):
            br, bi = cmul(co_re, co_im, flip_seq(bu[0], d), flip_seq(bu[1], d))
            a_shape = (1, br.shape[1]) + ab_re.shape
            ar, ai, xr, xi = lax.associative_scan(
                s5_combine, (jnp.broadcast_to(ab_re, a_shape), jnp.broadcast_to(ab_im, a_shape), br, bi), axis=1)
            if x0 is not None:
                pr, pm = cmul(ar, ai, x0[0][:, None], x0[1][:, None])
                xr, xi = xr + pr, xi + pm
            return xr, xi
        xcr, xci = run(buc, None)
        xlr, xli = run(bul, (xcr[:, -1], xci[:, -1]))
        yl = yl + flip_seq(c_read(xlr, xli), d)
        if with_ctx_out:
            yc = yc + flip_seq(c_read(xcr, xci), d)
    dsk = d_skip.astype(F32).reshape(S5_GROUPS, S5_CH)
    def glu(y, g, like):
        y = jax.nn.gelu((y + dsk * g).reshape(g.shape[:2] + (GROUP_W,)))
        return (y * jax.nn.sigmoid(y @ glu_w.astype(F32) + glu_b.astype(F32))).astype(like.dtype)
    return (glu(yc, gc, uc) if with_ctx_out else None), glu(yl, gl, ul)


def diff_softmax_blocks(q, k, v, lam):
    bsz, nq = q.shape[:2]
    nb = nq // Q_BLOCK
    scale = DA_DQK ** -0.5
    def block(qb):
        s = jnp.einsum('bqhmd,bkhmd->bhmqk', qb, k).astype(F32) * scale
        p = jax.nn.softmax(s, axis=-1)
        a = p[:, :, 0] - lam * p[:, :, 1]
        return jnp.einsum('bhqk,bkhv->bqhv', a.astype(v.dtype), v)
    qb = jnp.moveaxis(q.reshape((bsz, nb, Q_BLOCK) + q.shape[2:]), 1, 0)
    o = lax.map(block, qb)
    return jnp.moveaxis(o, 0, 1).reshape((bsz, nq) + o.shape[3:])


def diff_attention(zc, zl, lam_q1, lam_k1, lam_q2, lam_k2, norm_w, layer_idx, with_ctx_out):
    def split(z):
        q, k, v = jnp.split(z, 3, axis=-1)
        shp = z.shape[:2]
        return (q.reshape(shp + (DA_HEADS, 2, DA_DQK)), k.reshape(shp + (DA_HEADS, 2, DA_DQK)),
                v.reshape(shp + (DA_HEADS, DA_DV)))
    qc, kc, vc = split(zc)
    ql, kl, vl = split(zl)
    cos, sin = rope_2d(zl.shape[1], DA_DQK)
    ql, kl = apply_rope(ql, cos, sin), apply_rope(kl, cos, sin)
    lam_init = 0.8 - 0.6 * math.exp(-0.3 * layer_idx)
    lam = (jnp.exp(jnp.sum(lam_q1.astype(F32) * lam_k1.astype(F32)))
           - jnp.exp(jnp.sum(lam_q2.astype(F32) * lam_k2.astype(F32))) + lam_init)
    def readout(o):
        return head_rms_norm(o.reshape(o.shape[:2] + (-1,)), norm_w, DA_HEADS) * (1.0 - lam_init)
    out_l = readout(diff_softmax_blocks(ql, jnp.concatenate([kc, kl], axis=1),
                                        jnp.concatenate([vc, vl], axis=1), lam))
    out_c = readout(diff_softmax_blocks(qc, kc, vc, lam)) if with_ctx_out else None
    return out_c, out_l


def mlstm_chunked(q, k, v, log_i, log_f, state, with_out=True):
    bsz, t_len, nh, _ = q.shape
    nc = t_len // ML_CHUNK
    def chunks(a):
        return a.astype(F32).reshape((bsz, nc, ML_CHUNK) + a.shape[2:])
    q, k, v, log_i, log_f = chunks(q), chunks(k), chunks(v), chunks(log_i), chunks(log_f)
    b = jnp.cumsum(log_f, axis=2)
    b_end = b[:, :, -1]
    w_end = b_end[:, :, None] - b + log_i
    m_loc = jnp.max(w_end, axis=2)
    e_end = jnp.exp(w_end - m_loc[:, :, None])
    c_loc = jnp.einsum('bcshv,bcshd->bchvd', e_end[..., None] * v, k)
    n_loc = jnp.einsum('bcsh,bcshd->bchd', e_end, k)
    def step(carry, inp):
        c_st, n_st, m_st = carry
        be, ml, cl, nl = inp
        m_new = jnp.maximum(be + m_st, ml)
        a_old, a_loc = jnp.exp(be + m_st - m_new), jnp.exp(ml - m_new)
        c_new = a_old[..., None, None] * c_st + a_loc[..., None, None] * cl
        n_new = a_old[..., None] * n_st + a_loc[..., None] * nl
        return (c_new, n_new, m_new), carry
    mv = lambda a: jnp.moveaxis(a, 1, 0)
    final, starts = lax.scan(step, state, (mv(b_end), mv(m_loc), mv(c_loc), mv(n_loc)))
    if not with_out:
        return None, final
    c_s, n_s, m_s = (jnp.moveaxis(a, 0, 1) for a in starts)
    tri = jnp.tril(jnp.ones((ML_CHUNK, ML_CHUNK), bool))[None, None, :, :, None]
    d_log = jnp.where(tri, b[:, :, :, None] - b[:, :, None] + log_i[:, :, None], -jnp.inf)
    w_inter = b + m_s[:, :, None]
    m_t = jnp.maximum(w_inter, jnp.max(d_log, axis=3))
    e_inter = jnp.exp(w_inter - m_t)
    wts = jnp.exp(d_log - m_t[:, :, :, None]) * jnp.einsum('bcthd,bcshd->bctsh', q, k)
    num = (jnp.einsum('bctsh,bcshv->bcthv', wts, v)
           + e_inter[..., None] * jnp.einsum('bcthd,bchvd->bcthv', q, c_s))
    den = jnp.sum(wts, axis=3) + e_inter * jnp.einsum('bcthd,bchd->bcth', q, n_s)
    h = num / jnp.maximum(jnp.abs(den), jnp.exp(-m_t))[..., None]
    return h.reshape(bsz, t_len, nh, -1), final


def mlstm_mixer(zc, zl, norm_w, with_ctx_out):
    def split(z):
        shp = z.shape[:2]
        q, k, v, o = (z[..., j * GROUP_W:(j + 1) * GROUP_W] for j in range(4))
        gates = z[..., 4 * GROUP_W:].astype(F32).reshape(shp + (4, ML_HEADS))
        hd = lambda a: a.reshape(shp + (ML_HEADS, -1))
        return hd(q), hd(k) * ML_DK ** -0.5, hd(v), o, gates
    qc, kc, vc, oc, gtc = split(zc)
    ql, kl, vl, ol, gtl = split(zl)
    bsz = zc.shape[0]
    hc, hl = 0.0, 0.0
    for d in range(2):
        state0 = (jnp.zeros((bsz, ML_HEADS, ML_DV, ML_DK), F32), jnp.zeros((bsz, ML_HEADS, ML_DK), F32),
                  jnp.zeros((bsz, ML_HEADS), F32))
        h_c, st_c = mlstm_chunked(flip_seq(qc, d), flip_seq(kc, d), flip_seq(vc, d), flip_seq(gtc[:, :, d], d),
                                  flip_seq(jax.nn.log_sigmoid(gtc[:, :, 2 + d]), d), state0, with_ctx_out)
        h_l, _ = mlstm_chunked(flip_seq(ql, d), flip_seq(kl, d), flip_seq(vl, d), flip_seq(gtl[:, :, d], d),
                               flip_seq(jax.nn.log_sigmoid(gtl[:, :, 2 + d]), d), st_c)
        hl = hl + flip_seq(h_l, d)
        if with_ctx_out:
            hc = hc + flip_seq(h_c, d)
    def readout(h, o):
        h = h.reshape(h.shape[:2] + (-1,)).astype(o.dtype)
        return head_rms_norm(h, norm_w, ML_HEADS) * jax.nn.sigmoid(o)
    return (readout(hc, oc) if with_ctx_out else None), readout(hl, ol)


def expert_choice_moe(x, router_w, w1, w3, w2):
    bsz, n, _ = x.shape
    cap = EC_CAPACITY * n // N_EXPERTS
    aff = jax.nn.softmax((x @ router_w).astype(F32), axis=-1)
    gate, idx = lax.top_k(jnp.swapaxes(aff, 1, 2), cap)
    bidx = jnp.arange(bsz)[:, None, None]
    xs = x[bidx, idx]
    def expert(args):
        xe, w1e, w3e, w2e = args
        return (jax.nn.silu(xe @ w1e) * (xe @ w3e)) @ w2e
    ye = lax.map(expert, (jnp.swapaxes(xs, 0, 1), w1, w3, w2))
    ye = jnp.swapaxes(ye, 0, 1) * gate[..., None].astype(x.dtype)
    return jnp.zeros_like(x).at[bidx, idx].add(ye)


def setup_inputs(seed: int = 0) -> dict:
    key = jax.random.key(seed)
    it = iter(jax.random.split(key, 48))
    def nrm(shape, scale):
        return scale * jax.random.normal(next(it), shape, F32)
    L, D = DEPTH, D_MODEL
    x = nrm((BATCH, SEQ, D), 1.0)
    c = nrm((BATCH, D), 1.0)
    ctx = nrm((BATCH, CTX_LEN, D), 1.0)
    c_ctx = nrm((D,), 1.0)
    mod_w = nrm((L, D, 6 * D), 0.5 * D ** -0.5)
    mod_b = nrm((L, 6 * D), 0.02)
    norm1_w = 1.0 + nrm((L, D), 0.02)
    norm2_w = 1.0 + nrm((L, D), 0.02)
    w_in = nrm((L, D, IN_COLS), D ** -0.5)
    fg_bias = jnp.linspace(3.0, 6.0, ML_HEADS, dtype=F32)
    b_in = nrm((L, IN_COLS), 0.02).at[:, ML_GATE_OFF + 2 * ML_HEADS:].add(jnp.concatenate([fg_bias, fg_bias]))
    hg_lb_logits = nrm((L, 2, GROUP_W), 1.0)
    hg_norm_w = 1.0 + nrm((L, GROUP_W), 0.02)
    s5_lam_re = -0.5 + nrm((L, 2, S5_GROUPS, S5_STATE), 0.01)
    s5_lam_im = math.pi * jnp.arange(S5_STATE, dtype=F32) + nrm((L, 2, S5_GROUPS, S5_STATE), 0.01)
    s5_log_dt = math.log(DT_MIN) + (math.log(DT_MAX) - math.log(DT_MIN)) * jax.random.uniform(
        next(it), (L, 2, S5_GROUPS), F32)
    s5_b_re = nrm((L, S5_GROUPS, S5_STATE, S5_CH), (2 * S5_CH) ** -0.5)
    s5_b_im = nrm((L, S5_GROUPS, S5_STATE, S5_CH), (2 * S5_CH) ** -0.5)
    s5_c_re = nrm((L, S5_GROUPS, S5_CH, S5_STATE), (2 * S5_STATE) ** -0.5)
    s5_c_im = nrm((L, S5_GROUPS, S5_CH, S5_STATE), (2 * S5_STATE) ** -0.5)
    s5_d = nrm((L, GROUP_W), 1.0)
    s5_glu_w = nrm((L, GROUP_W, GROUP_W), GROUP_W ** -0.5)
    s5_glu_b = nrm((L, GROUP_W), 0.02)
    da_lq1 = nrm((L, DA_DQK), 0.1)
    da_lk1 = nrm((L, DA_DQK), 0.1)
    da_lq2 = nrm((L, DA_DQK), 0.1)
    da_lk2 = nrm((L, DA_DQK), 0.1)
    da_norm_w = 1.0 + nrm((L, GROUP_W), 0.02)
    ml_norm_w = 1.0 + nrm((L, GROUP_W), 0.02)
    w_out = nrm((L, MIX_W, D), MIX_W ** -0.5)
    router_w = nrm((L, D, N_EXPERTS), D ** -0.5)
    exp_w1 = nrm((L, N_EXPERTS, D, D_EXPERT), D ** -0.5)
    exp_w3 = nrm((L, N_EXPERTS, D, D_EXPERT), D ** -0.5)
    exp_w2 = nrm((L, N_EXPERTS, D_EXPERT, D), D_EXPERT ** -0.5)
    final_norm_w = 1.0 + nrm((D,), 0.02)
    return {'x': x, 'c': c, 'ctx': ctx, 'c_ctx': c_ctx, 'mod_w': mod_w, 'mod_b': mod_b,
            'norm1_w': norm1_w, 'norm2_w': norm2_w, 'w_in': w_in, 'b_in': b_in,
            'hg_lb_logits': hg_lb_logits, 'hg_norm_w': hg_norm_w,
            's5_lam_re': s5_lam_re, 's5_lam_im': s5_lam_im, 's5_log_dt': s5_log_dt,
            's5_b_re': s5_b_re, 's5_b_im': s5_b_im, 's5_c_re': s5_c_re, 's5_c_im': s5_c_im,
            's5_d': s5_d, 's5_glu_w': s5_glu_w, 's5_glu_b': s5_glu_b,
            'da_lq1': da_lq1, 'da_lk1': da_lk1, 'da_lq2': da_lq2, 'da_lk2': da_lk2, 'da_norm_w': da_norm_w,
            'ml_norm_w': ml_norm_w, 'w_out': w_out, 'router_w': router_w,
            'exp_w1': exp_w1, 'exp_w3': exp_w3, 'exp_w2': exp_w2, 'final_norm_w': final_norm_w}


def reference(x, c, ctx, c_ctx, mod_w, mod_b, norm1_w, norm2_w, w_in, b_in, hg_lb_logits, hg_norm_w,
              s5_lam_re, s5_lam_im, s5_log_dt, s5_b_re, s5_b_im, s5_c_re, s5_c_im, s5_d, s5_glu_w, s5_glu_b,
              da_lq1, da_lk1, da_lq2, da_lk2, da_norm_w, ml_norm_w, w_out, router_w,
              exp_w1, exp_w3, exp_w2, final_norm_w):
    lb_all = jnp.cumsum(jax.nn.softmax(hg_lb_logits.astype(F32), axis=0), axis=0)
    lb_all = lb_all - lb_all[0]
    hl, hc = x, ctx
    sc, scc = jax.nn.silu(c), jax.nn.silu(c_ctx)
    for li in range(DEPTH):
        ctx_out = li < DEPTH - 1
        mod_l = jnp.split((sc @ mod_w[li] + mod_b[li])[:, None, :], 6, axis=-1)
        mod_c = jnp.split(scc @ mod_w[li] + mod_b[li], 6, axis=-1)
        zl = modulated(hl, norm1_w[li], mod_l[0], mod_l[1]) @ w_in[li] + b_in[li]
        zc = modulated(hc, norm1_w[li], mod_c[0], mod_c[1]) @ w_in[li] + b_in[li]
        a_c, a_l = hgrn2_mixer(zc[..., HG_OFF:S5_OFF], zl[..., HG_OFF:S5_OFF], lb_all[li], hg_norm_w[li], ctx_out)
        b_c, b_l = s5_mixer(zc[..., S5_OFF:DA_OFF], zl[..., S5_OFF:DA_OFF], s5_lam_re[li], s5_lam_im[li],
                            s5_log_dt[li], s5_b_re[li], s5_b_im[li], s5_c_re[li], s5_c_im[li], s5_d[li],
                            s5_glu_w[li], s5_glu_b[li], ctx_out)
        c_c, c_l = diff_attention(zc[..., DA_OFF:ML_OFF], zl[..., DA_OFF:ML_OFF], da_lq1[li], da_lk1[li],
                                  da_lq2[li], da_lk2[li], da_norm_w[li], li, ctx_out)
        d_c, d_l = mlstm_mixer(zc[..., ML_OFF:IN_COLS], zl[..., ML_OFF:IN_COLS], ml_norm_w[li], ctx_out)
        hl = hl + mod_l[2] * (jnp.concatenate([a_l, b_l, c_l, d_l], axis=-1) @ w_out[li])
        hl = hl + mod_l[5] * expert_choice_moe(modulated(hl, norm2_w[li], mod_l[3], mod_l[4]),
                                               router_w[li], exp_w1[li], exp_w3[li], exp_w2[li])
        if ctx_out:
            hc = hc + mod_c[2] * (jnp.concatenate([a_c, b_c, c_c, d_c], axis=-1) @ w_out[li])
            hc = hc + mod_c[5] * expert_choice_moe(modulated(hc, norm2_w[li], mod_c[3], mod_c[4]),
                                                   router_w[li], exp_w1[li], exp_w3[li], exp_w2[li])
    return rms_norm(hl, final_norm_w)
```

```cpp
#include <hip/hip_runtime.h>
#include <cstdio>
#include <cstdint>

#define LAS __attribute__((address_space(3)))
#define GAS __attribute__((address_space(1)))
typedef unsigned short bf16_t;
typedef short bf16x8 __attribute__((ext_vector_type(8)));
typedef float f32x4 __attribute__((ext_vector_type(4)));
typedef float f32x2 __attribute__((ext_vector_type(2)));
typedef unsigned u32x4 __attribute__((ext_vector_type(4)));
typedef unsigned u32x2 __attribute__((ext_vector_type(2)));
#define DI __device__ __forceinline__

constexpr int NB = 16, NL = 2048, NC = 256, D = 1024, DEPTH = 2;
constexpr int NLAT = NB * NL;
constexpr int NCTX = NB * NC;
constexpr int NTOK = NLAT + NCTX;
constexpr int ZC = 3328;
constexpr int INC = 3344;
constexpr int GW = 256;
constexpr int Z_HGQ = 0, Z_HGI = 256, Z_HGF = 512, Z_HGG = 1024, Z_S5 = 1280, Z_DAQ = 1536, Z_DAK = 1792, Z_DAV = 2048, Z_MLQ = 2304, Z_MLK = 2560, Z_MLV = 2816, Z_MLO = 3072;
constexpr int NE = 16, DE = 2048;
constexpr float EPS = 1e-6f;

constexpr size_t MiB = 1u << 20;
constexpr size_t WS_CTL = 0, CTL_BYTES = 1 * MiB;
constexpr size_t WS_MOD = 1 * MiB;
constexpr size_t WS_ROPE = 2 * MiB;
constexpr size_t WS_LB = 2 * MiB + 512 * 1024;
constexpr size_t WS_AFF = 3 * MiB;
constexpr size_t WS_GATE = 7 * MiB;
constexpr size_t WS_RSRC = 7 * MiB + 512 * 1024;
constexpr size_t WS_INV = 8 * MiB;
constexpr size_t WS_ZG = 12 * MiB;
constexpr size_t WS_WIN = 15 * MiB;
constexpr size_t WS_WOUT = 28 * MiB;
constexpr size_t WS_W13 = 40 * MiB;
constexpr size_t WS_W2 = 168 * MiB;
constexpr size_t WS_HL = 232 * MiB;
constexpr size_t WS_XN = 376 * MiB;
constexpr size_t WS_ARENA = 448 * MiB;
constexpr size_t WS_Z = WS_ARENA;
constexpr size_t WS_MIX = WS_ARENA + 234 * MiB;
constexpr size_t WS_T0 = WS_ARENA + 306 * MiB;
constexpr size_t WS_T1 = WS_ARENA + 378 * MiB;
constexpr size_t WS_T2 = WS_ARENA + 450 * MiB;
constexpr size_t WS_XS = WS_ARENA;
constexpr size_t WS_H = WS_ARENA + 144 * MiB;
constexpr size_t WS_END = WS_ARENA + 522 * MiB;
constexpr size_t WS_GLUW = WS_T2 + 68 * MiB;
constexpr int P0_SKIP = 8448 + 9216;
constexpr int CW_BAR = 4096;

constexpr int NWAVES = 8, NTHR = 512;
constexpr int LDS_BYTES = 147456 + 512;
constexpr int RING_BYTES = 131072;
constexpr int MISC_OFF = LDS_BYTES - 256;

DI unsigned f2bf(float f) { unsigned u = __builtin_bit_cast(unsigned, f); return (u + 0x7fffu + ((u >> 16) & 1u)) >> 16; }
DI unsigned pk2(float lo, float hi) { return f2bf(lo) | (f2bf(hi) << 16); }
DI float bf2f(unsigned short b) { return __builtin_bit_cast(float, (unsigned)b << 16); }
DI float bflo(unsigned w) { return __builtin_bit_cast(float, w << 16); }
DI float bfhi(unsigned w) { return __builtin_bit_cast(float, w & 0xffff0000u); }
DI float dpp_add(float v, const int ctrl_tag) {
    const int x = __builtin_bit_cast(int, v); int t;
    if (ctrl_tag == 0) t = __builtin_amdgcn_update_dpp(0, x, 0xB1, 0xF, 0xF, true);
    else if (ctrl_tag == 1) t = __builtin_amdgcn_update_dpp(0, x, 0x4E, 0xF, 0xF, true);
    else if (ctrl_tag == 2) t = __builtin_amdgcn_update_dpp(0, x, 0x141, 0xF, 0xF, true);
    else t = __builtin_amdgcn_update_dpp(0, x, 0x140, 0xF, 0xF, true);
    return v + __builtin_bit_cast(float, t);
}
DI float dpp_perm(float v, const int ctrl_tag) {
    const int x = __builtin_bit_cast(int, v);
    const int t = ctrl_tag == 2 ? __builtin_amdgcn_update_dpp(0, x, 0x141, 0xF, 0xF, true) : __builtin_amdgcn_update_dpp(0, x, 0x140, 0xF, 0xF, true);
    return __builtin_bit_cast(float, t);
}
DI float row_lane(float v, int l) { return __builtin_bit_cast(float, __builtin_amdgcn_readlane(__builtin_bit_cast(int, v), l)); }
DI float wave_sum(float v) {
    v = dpp_add(v, 0); v = dpp_add(v, 1); v = dpp_add(v, 2); v = dpp_add(v, 3);
    const int x = __builtin_bit_cast(int, v);
    const float r0 = __builtin_bit_cast(float, __builtin_amdgcn_readlane(x, 0)), r1 = __builtin_bit_cast(float, __builtin_amdgcn_readlane(x, 16)), r2 = __builtin_bit_cast(float, __builtin_amdgcn_readlane(x, 32)), r3 = __builtin_bit_cast(float, __builtin_amdgcn_readlane(x, 48));
    return (r0 + r1) + (r2 + r3);
}
DI float sigmoidf_(float x) { return __builtin_amdgcn_rcpf(1.0f + __expf(-x)); }
DI float siluf_(float x) { return x * __builtin_amdgcn_rcpf(1.0f + __expf(-x)); }
namespace pg8 {
#define PG8_LAS __attribute__((address_space(3)))
constexpr int BM = 256, BK = 64, HALF = 128, HTB = HALF * BK * 2, STAGE_BYTES = 8 * HTB, NXCD = 8, WGM = 8;
__host__ __device__ __forceinline__ int lds_byte(int r, int c) { const int st = (r >> 4) * 2 + (c >> 5), rr = r & 15, cc = c & 31, ob = rr * 64 + cc * 2; return st * 1024 + (ob ^ (((ob >> 9) & 1) << 5)); }
__host__ __device__ __forceinline__ void stage_rc(int b, int& R, int& C) { const int st = b / 1024, sb = b % 1024, swz = sb ^ (((sb >> 9) & 1) << 5); R = (st >> 1) * 16 + swz / 64; C = (st & 1) * 32 + (swz % 64) / 2; }
__host__ __device__ __forceinline__ int perm32(int rho) { const int n = rho >> 4, i = rho & 15; return 8 * (i >> 2) + 4 * n + (i & 3); }
struct Unit { int pm, pn, g; };
struct GemmDesc { int K, lda, ldb; };
struct DenseOrder {
    static constexpr bool GATHER = false; __device__ __forceinline__ const int* row_tab(const Unit&) const { return nullptr; }
    int nM, nN, nwg, G, c; const char* A; const char* B; size_t ta, tb;
    __device__ void init(int M, int N, int G_, int c_, const void* A_, size_t lda, const void* B_, size_t ldb) { nM = M / BM; nN = N / BM; nwg = nM * nN; G = G_; c = c_; A = (const char*)A_; B = (const char*)B_; ta = (size_t)BM * lda * 2; tb = (size_t)BM * ldb * 2; }
    __device__ bool next(int i, Unit& u) const {
        const long L = (long)i * G + c; if (L >= nwg) return false;
        int wgid = (int)L; { const int q = nwg / NXCD, r = nwg % NXCD, xcd = wgid % NXCD, off = wgid / NXCD; wgid = (xcd < r ? xcd * (q + 1) : r * (q + 1) + (xcd - r) * q) + off; }
        const int nig = WGM * nN, gid = wgid / nig, fm = gid * WGM, gsz = (nM - fm) < WGM ? (nM - fm) : WGM;
        u.pm = fm + ((wgid % nig) % gsz); u.pn = (wgid % nig) / gsz; u.g = 0; return true;
    }
    __device__ __forceinline__ const char* a_ptr(const Unit& u) const { return A + (size_t)u.pm * ta; }
    __device__ __forceinline__ const char* b_ptr(const Unit& u) const { return B + (size_t)u.pn * tb; }
    __device__ __forceinline__ void a_ready(const Unit&) const {}
    __device__ __forceinline__ void done(const Unit&) const {}
};
struct InProjLastOrder {
    static constexpr bool GATHER = false; __device__ __forceinline__ const int* row_tab(const Unit&) const { return nullptr; }
    DenseOrder lat; int G, c;
    __device__ bool next(int i, Unit& u) const {
        const long L = (long)i * G + c;
        if (L < lat.nwg) return lat.next(i, u);
        const int r = (int)(L - lat.nwg); if (r >= 16 * 8) return false;
        const int tab = r & 7; u.pm = 128 + (r >> 3); u.pn = tab == 0 ? 1 : tab == 1 ? 2 : tab == 2 ? 3 : tab == 3 ? 5 : tab == 4 ? 7 : tab == 5 ? 8 : tab == 6 ? 10 : 11; u.g = 0; return true;
    }
    __device__ __forceinline__ const char* a_ptr(const Unit& u) const { return lat.a_ptr(u); }
    __device__ __forceinline__ const char* b_ptr(const Unit& u) const { return lat.b_ptr(u); }
    __device__ __forceinline__ void a_ready(const Unit&) const {}
    __device__ __forceinline__ void done(const Unit&) const {}
};
template <bool GATH> struct MoeOrder {
    static constexpr bool GATHER = GATH; const int* tab;
    __device__ __forceinline__ const int* row_tab(const Unit& u) const { return tab + (size_t)(u.g * MT + u.pm) * 256; }
    int MT, NT, G, c; const char* A; const char* B; size_t ta, ga, tb, gb;
    __device__ bool next(int i, Unit& u) const {
        const int per = MT * NT;
        if (G == 256) {
            const int xg = c & 7, r = c >> 3, idx = i * 32 + r; if (idx >= 2 * per) return false;
            const int el = idx / per, v = idx % per; u.g = xg * 2 + el;
            if (NT == 16) { const int blk = v / (MT * 8), w = v % (MT * 8); u.pm = w / 8; u.pn = blk * 8 + (w % 8); }
            else { u.pm = v / NT; u.pn = v % NT; }
            return true;
        }
        const long L = (long)i * G + c; if (L >= (long)16 * per) return false;
        u.g = (int)(L / per); const int v = (int)(L % per); u.pm = v / NT; u.pn = v % NT; return true;
    }
    __device__ __forceinline__ const char* a_ptr(const Unit& u) const { return GATH ? A : A + (size_t)u.g * ga + (size_t)u.pm * ta; }
    __device__ __forceinline__ const char* b_ptr(const Unit& u) const { return B + (size_t)u.g * gb + (size_t)u.pn * tb; }
    __device__ __forceinline__ void a_ready(const Unit&) const {}
    __device__ __forceinline__ void done(const Unit&) const {}
};
__device__ __forceinline__ unsigned cvt_pk_bf16(float lo, float hi) { unsigned r; asm volatile("v_cvt_pk_bf16_f32 %0, %1, %2" : "=v"(r) : "v"(lo), "v"(hi)); return r; }
typedef __bf16 bf16v2 __attribute__((ext_vector_type(2)));
__device__ __forceinline__ unsigned cvt_pk_nv(float lo, float hi) { const bf16v2 v = {(__bf16)lo, (__bf16)hi}; return __builtin_bit_cast(unsigned, v); }
template <class Epi, class Sched, bool ALIGN_EPI = false, bool SP2 = false>
__device__ __forceinline__ void gemm_phase(PG8_LAS unsigned char* lds, const GemmDesc g, const Sched& S, const Epi& E) {
    const int tid = threadIdx.x, wid = __builtin_amdgcn_readfirstlane(tid >> 6), lane = tid & 63, wr = wid >> 2, wc = wid & 3, fr = lane & 15, fq = lane >> 4;
    int Kop = g.K; asm volatile("" : "+s"(Kop));
    const int K = Kop, nt = K / BK;
    unsigned vA0[2], vA1[2], nA0[2], nA1[2], voffB[2]; int Rr[2]; unsigned colb[2];
#pragma unroll
    for (int i = 0; i < 2; ++i) { int R, C; stage_rc(tid * 16 + i * 8192, R, C); const int Rb = Epi::PERM ? ((R & ~31) + perm32(R & 31)) : R; Rr[i] = R; colb[i] = (unsigned)C * 2u;
        vA0[i] = (unsigned)(R * g.lda + C) * 2u; vA1[i] = vA0[i] + (unsigned)(HALF * g.lda * 2); voffB[i] = (unsigned)(Rb * g.ldb + C) * 2u; }
#define PG8_GATHER(u, v0, v1) do { const int* _tab = S.row_tab(u); _Pragma("unroll") for (int _i = 0; _i < 2; ++_i) { (v0)[_i] = (unsigned)_tab[Rr[_i]] * (unsigned)(g.lda * 2) + colb[_i]; (v1)[_i] = (unsigned)_tab[HALF + Rr[_i]] * (unsigned)(g.lda * 2) + colb[_i]; } } while (0)
    const size_t kstep = (size_t)(BK * 2);
    const size_t hstepB = (size_t)HALF * g.ldb * 2;
    const unsigned ldsw = (unsigned)wid * 1024u;
    const int aoff = lds_byte(wr * 64 + fr, fq * 8), boff = lds_byte(wc * 32 + fr, fq * 8);
#define PG8_SA(b, h) (((b) * 2 + (h)) * HTB)
#define PG8_SB(b, h) ((4 + (b) * 2 + (h)) * HTB)
#define PG8_STAGE(bufoff, gbase, voff) do { _Pragma("unroll") for (int _i = 0; _i < 2; ++_i) \
        __builtin_amdgcn_global_load_lds((const unsigned*)((const char*)(gbase) + (voff)[_i]), (PG8_LAS unsigned*)(lds + (bufoff) + ldsw + _i * 8192), 16, 0, 0); } while (0)
#define PG8_LDA(dst, b, h) do { _Pragma("unroll") for (int m = 0; m < 4; ++m) _Pragma("unroll") for (int k = 0; k < 2; ++k) dst[m][k] = *(const PG8_LAS bf16x8*)(lds + PG8_SA(b, h) + aoff + m * 2048 + k * 1024); } while (0)
#define PG8_LDB(dst, b, h) do { _Pragma("unroll") for (int n = 0; n < 2; ++n) _Pragma("unroll") for (int k = 0; k < 2; ++k) dst[n][k] = *(const PG8_LAS bf16x8*)(lds + PG8_SB(b, h) + boff + n * 2048 + k * 1024); } while (0)
#define PG8_MMA(ai, bj, At, Bt) do { __builtin_amdgcn_s_setprio(1); _Pragma("unroll") for (int m = 0; m < 4; ++m) _Pragma("unroll") for (int n = 0; n < 2; ++n) _Pragma("unroll") for (int k = 0; k < 2; ++k) \
        acc[ai][bj][m][n] = __builtin_amdgcn_mfma_f32_16x16x32_bf16(Bt[n][k], At[m][k], acc[ai][bj][m][n], 0, 0, 0); __builtin_amdgcn_s_setprio(0); } while (0)
#define PG8_WAIT_V(n) asm volatile("s_waitcnt vmcnt(" #n ")" ::: "memory")
#define PG8_WAIT_L(n) asm volatile("s_waitcnt lgkmcnt(" #n ")" ::: "memory")
#define PG8_BAR __builtin_amdgcn_s_barrier()
#define PG8_SCHED __builtin_amdgcn_sched_barrier(0)
    Unit cur, nxt; int ui = 0;
    if (!S.next(0, cur)) return;
    f32x4 acc[2][2][4][2];
#pragma unroll
    for (int a = 0; a < 2; ++a)
#pragma unroll
        for (int b = 0; b < 2; ++b)
#pragma unroll
            for (int m = 0; m < 4; ++m)
#pragma unroll
                for (int n = 0; n < 2; ++n) acc[a][b][m][n] = (f32x4){0.f, 0.f, 0.f, 0.f};
    bf16x8 At[4][2], B0[2][2], B1[2][2];
    const char* cA = S.a_ptr(cur); const char* cB = S.b_ptr(cur);
    if constexpr (Sched::GATHER) PG8_GATHER(cur, vA0, vA1);
#pragma unroll
    for (int i = 0; i < 2; ++i) { nA0[i] = vA0[i]; nA1[i] = vA1[i]; }
    S.a_ready(cur);
    if constexpr (SP2) {
        PG8_STAGE(PG8_SB(0, 0), cB, voffB); PG8_STAGE(PG8_SB(0, 1), cB + hstepB, voffB); PG8_STAGE(PG8_SA(0, 0), cA, vA0); PG8_STAGE(PG8_SA(0, 1), cA, vA1);
        if (wr == 1) PG8_BAR;
        PG8_WAIT_V(2); PG8_BAR;
        PG8_STAGE(PG8_SB(1, 0), cB + kstep, voffB); PG8_STAGE(PG8_SA(1, 0), cA + kstep, vA0); PG8_STAGE(PG8_SB(1, 1), cB + hstepB + kstep, voffB);
        PG8_WAIT_V(6); PG8_BAR;
    } else {
        PG8_STAGE(PG8_SB(0, 0), cB, voffB); PG8_STAGE(PG8_SA(0, 0), cA, vA0); PG8_STAGE(PG8_SB(0, 1), cB + hstepB, voffB); PG8_STAGE(PG8_SA(0, 1), cA, vA1);
        if (wr == 1) PG8_BAR;
        PG8_WAIT_V(4); PG8_BAR;
        PG8_STAGE(PG8_SB(1, 0), cB + kstep, voffB); PG8_STAGE(PG8_SA(1, 0), cA + kstep, vA0); PG8_STAGE(PG8_SB(1, 1), cB + hstepB + kstep, voffB);
        PG8_WAIT_V(6); PG8_BAR;
    }
    for (;;) {
        const bool has_next = S.next(ui + 1, nxt);
        const char* nA = has_next ? S.a_ptr(nxt) : cA; const char* nB = has_next ? S.b_ptr(nxt) : cB;
        if constexpr (Sched::GATHER) { if (has_next) PG8_GATHER(nxt, nA0, nA1); }
#pragma unroll 1
        for (int t = 0; t < nt; t += 2) {
            const bool last = (t == nt - 2);
            const char* a1 = cA + (size_t)(t + 1) * kstep;
            const char* a2 = last ? nA : cA + (size_t)(t + 2) * kstep; const char* b2 = last ? nB : cB + (size_t)(t + 2) * kstep;
            const char* a3 = a2 + kstep; const char* b3 = b2 + kstep;
            unsigned w0[2], w1[2];
#pragma unroll
            for (int i = 0; i < 2; ++i) { w0[i] = vA0[i]; w1[i] = vA1[i]; }
            if constexpr (Sched::GATHER) { if (last) { asm volatile("" ::: "memory");
#pragma unroll
                for (int i = 0; i < 2; ++i) { w0[i] = nA0[i]; w1[i] = nA1[i]; } } }
            if (last && has_next) S.a_ready(nxt);
            if constexpr (SP2) {
            PG8_LDB(B0, 0, 0); PG8_LDB(B1, 0, 1); PG8_SCHED; PG8_LDA(At, 0, 0); PG8_STAGE(PG8_SA(1, 1), a1, vA1);
            PG8_WAIT_V(8); PG8_WAIT_L(0); PG8_BAR; PG8_MMA(0, 0, At, B0); PG8_MMA(0, 1, At, B1); PG8_BAR; PG8_SCHED;
            PG8_LDA(At, 0, 1); PG8_STAGE(PG8_SB(0, 0), b2, voffB); PG8_STAGE(PG8_SB(0, 1), b2 + hstepB, voffB); PG8_STAGE(PG8_SA(0, 0), a2, w0);
            PG8_WAIT_V(8); PG8_WAIT_L(0); PG8_BAR; PG8_MMA(1, 0, At, B0); PG8_MMA(1, 1, At, B1); PG8_BAR; PG8_SCHED;
            PG8_LDB(B0, 1, 0); PG8_LDB(B1, 1, 1); PG8_SCHED; PG8_LDA(At, 1, 0); PG8_STAGE(PG8_SA(0, 1), a2, w1);
            PG8_WAIT_V(8); PG8_WAIT_L(0); PG8_BAR; PG8_MMA(0, 0, At, B0); PG8_MMA(0, 1, At, B1); PG8_BAR; PG8_SCHED;
            PG8_LDA(At, 1, 1); PG8_STAGE(PG8_SB(1, 0), b3, voffB); PG8_STAGE(PG8_SB(1, 1), b3 + hstepB, voffB); PG8_STAGE(PG8_SA(1, 0), a3, w0);
            PG8_WAIT_V(8); PG8_WAIT_L(0); PG8_BAR; PG8_MMA(1, 0, At, B0); PG8_MMA(1, 1, At, B1); PG8_BAR; PG8_SCHED;
            } else {
            PG8_LDB(B0, 0, 0); PG8_SCHED; PG8_LDA(At, 0, 0); PG8_STAGE(PG8_SA(1, 1), a1, vA1);
            PG8_WAIT_L(8); PG8_BAR; PG8_WAIT_L(0); PG8_MMA(0, 0, At, B0); PG8_BAR; PG8_SCHED;
            PG8_LDB(B1, 0, 1); PG8_STAGE(PG8_SB(0, 0), b2, voffB);
            PG8_BAR; PG8_WAIT_L(0); PG8_MMA(0, 1, At, B1); PG8_BAR;
            PG8_LDA(At, 0, 1); PG8_STAGE(PG8_SA(0, 0), a2, w0);
            PG8_BAR; PG8_WAIT_L(0); PG8_MMA(1, 0, At, B0); PG8_BAR; PG8_SCHED;
            PG8_STAGE(PG8_SB(0, 1), b2 + hstepB, voffB);
            PG8_WAIT_V(6); PG8_BAR; PG8_MMA(1, 1, At, B1); PG8_BAR;
            PG8_LDB(B0, 1, 0); PG8_SCHED; PG8_LDA(At, 1, 0); PG8_STAGE(PG8_SA(0, 1), a2, w1);
            PG8_WAIT_L(8); PG8_BAR; PG8_WAIT_L(0); PG8_MMA(0, 0, At, B0); PG8_BAR; PG8_SCHED;
            PG8_LDB(B1, 1, 1); PG8_STAGE(PG8_SB(1, 0), b3, voffB);
            PG8_BAR; PG8_WAIT_L(0); PG8_MMA(0, 1, At, B1); PG8_BAR;
            PG8_LDA(At, 1, 1); PG8_STAGE(PG8_SA(1, 0), a3, w0);
            PG8_BAR; PG8_WAIT_L(0); PG8_MMA(1, 0, At, B0); PG8_BAR; PG8_SCHED;
            PG8_STAGE(PG8_SB(1, 1), b3 + hstepB, voffB);
            PG8_WAIT_V(6); PG8_BAR; PG8_MMA(1, 1, At, B1); PG8_BAR;
            }
        }
        if constexpr (ALIGN_EPI) { if (wr == 0) PG8_BAR; }
        if constexpr (!Epi::AFTER_DRAIN) { E(acc, cur, wr, wc, fr, fq); S.done(cur); }
        if (!has_next) break;
#pragma unroll
        for (int a = 0; a < 2; ++a)
#pragma unroll
            for (int b = 0; b < 2; ++b)
#pragma unroll
                for (int m = 0; m < 4; ++m)
#pragma unroll
                    for (int n = 0; n < 2; ++n) acc[a][b][m][n] = (f32x4){0.f, 0.f, 0.f, 0.f};
        cur = nxt; cA = nA; cB = nB; ++ui;
        if constexpr (Sched::GATHER) {
#pragma unroll
            for (int i = 0; i < 2; ++i) { vA0[i] = nA0[i]; vA1[i] = nA1[i]; } }
        if constexpr (ALIGN_EPI) { if (wr == 1) PG8_BAR; }
    }
    PG8_WAIT_V(0);
    if constexpr (!ALIGN_EPI) { if (wr == 0) PG8_BAR; }
    PG8_BAR;
    if constexpr (Epi::AFTER_DRAIN) { E.fused(acc, cur, wr, wc, fr, fq, lds, wid, lane); S.done(cur); }
#undef PG8_SA
#undef PG8_GATHER
#undef PG8_SB
#undef PG8_STAGE
#undef PG8_LDA
#undef PG8_LDB
#undef PG8_MMA
#undef PG8_WAIT_V
#undef PG8_WAIT_L
#undef PG8_BAR
#undef PG8_SCHED
}
}
struct Frame {
    LAS unsigned char* lds; unsigned char* ws; const float* const* in; float* out;
    int tid, lane, wave, bid, G;
};
#define LDS_WAIT() asm volatile("s_waitcnt lgkmcnt(0)" ::: "memory")
enum { I_X = 0, I_C, I_CTX, I_CCTX, I_MODW, I_MODB, I_N1W, I_N2W, I_WIN, I_BIN, I_HGLB, I_HGNW, I_S5LR, I_S5LI, I_S5DT, I_S5BR, I_S5BI, I_S5CR, I_S5CI, I_S5D, I_S5GW, I_S5GB,
       I_LQ1, I_LK1, I_LQ2, I_LK2, I_DANW, I_MLNW, I_WOUT, I_RTW, I_W1, I_W3, I_W2, I_FNW, N_IN };

DI int mod_idx(int row) { return row < NLAT ? (row >> 11) : 16; }
DI int seq_row(int b, int d, int p) {
    if (p < NC) return NLAT + b * NC + (d ? (NC - 1 - p) : p);
    const int t = p - NC; return b * NL + (d ? (NL - 1 - t) : t);
}
DI int xs_row(int e, int s, int j, int MT) { return s < 16 ? (e * MT + s) * 256 + j : (e * MT + 16 + ((s - 16) >> 3)) * 256 + ((s - 16) & 7) * 32 + j; }

DI float reduce16(float (&v)[16], int lane) {
#pragma unroll
    for (int i = 0; i < 8; ++i) { const bool hi = (lane & 32) != 0; const float keep = hi ? v[i + 8] : v[i], send = hi ? v[i] : v[i + 8]; v[i] = keep + __shfl_xor(send, 32); }
#pragma unroll
    for (int i = 0; i < 4; ++i) { const bool hi = (lane & 16) != 0; const float keep = hi ? v[i + 4] : v[i], send = hi ? v[i] : v[i + 4]; v[i] = keep + __shfl_xor(send, 16); }
#pragma unroll
    for (int i = 0; i < 2; ++i) { const bool hi = (lane & 8) != 0; const float keep = hi ? v[i + 2] : v[i], send = hi ? v[i] : v[i + 2]; v[i] = keep + __shfl_xor(send, 8); }
    const bool hi = (lane & 4) != 0; const float keep = hi ? v[1] : v[0], send = hi ? v[0] : v[1];
    float r = keep + __shfl_xor(send, 4);
    r += __shfl_xor(r, 2); r += __shfl_xor(r, 1);
    return r;
}

constexpr size_t WS_S5 = WS_T2;
constexpr size_t WS_S5A = WS_S5;
constexpr size_t WS_S5B = WS_S5 + 4 * MiB;
constexpr size_t WS_S5P = WS_S5 + 12 * MiB;
constexpr size_t WS_ACAT = WS_S5 + 13 * MiB;
constexpr size_t WS_XLOC = WS_S5 + 49 * MiB;
constexpr int NCHK = NTOK / 16;
DI void s5_tables_job(const Frame& F, int job8) {
    const int job = job8 >> 3, part = job8 & 7, li = job >> 4, g = job & 15;
    LAS f32x2* apw = (LAS f32x2*)F.lds;
    LAS f32x2* Bt = apw + 2 * 64 * 17;
    LAS f32x2* Cc = Bt + 2 * 64 * 16;
    LAS float* Kt = (LAS float*)(Cc + 16 * 64);
    if (F.tid < 128) {
        const int d = F.tid >> 6, p = F.tid & 63;
        const float lr = F.in[I_S5LR][((li * 2 + d) * 16 + g) * 64 + p], lim = F.in[I_S5LI][((li * 2 + d) * 16 + g) * 64 + p], dt = expf(F.in[I_S5DT][(li * 2 + d) * 16 + g]);
        const float mag = expf(lr * dt), ar = mag * cosf(lim * dt), ai = mag * sinf(lim * dt), den = lr * lr + lim * lim;
        const float cor = ((ar - 1.0f) * lr + ai * lim) / den, coi = (ai * lr - (ar - 1.0f) * lim) / den;
        float pr = 1.0f, pi = 0.0f;
        for (int tau = 0; tau <= 16; ++tau) { apw[(d * 64 + p) * 17 + tau] = (f32x2){pr, pi}; const float nr = pr * ar - pi * ai, ni = pr * ai + pi * ar; pr = nr; pi = ni; }
        for (int c = 0; c < 16; ++c) { const float xr = F.in[I_S5BR][((li * 16 + g) * 64 + p) * 16 + c], xi = F.in[I_S5BI][((li * 16 + g) * 64 + p) * 16 + c]; Bt[(d * 64 + p) * 16 + c] = (f32x2){cor * xr - coi * xi, cor * xi + coi * xr}; }
        if (part == 0) ((f32x2*)(F.ws + WS_S5P))[((li * 16 + g) * 2 + d) * 64 + p] = apw[(d * 64 + p) * 17 + 16];
    }
    for (int i = F.tid; i < 1024; i += NTHR) Cc[i] = (f32x2){F.in[I_S5CR][(li * 16 + g) * 1024 + i], F.in[I_S5CI][(li * 16 + g) * 1024 + i]};
    __syncthreads();
    for (int i = F.tid; i < 512; i += NTHR) {
        const int d = i >> 8, tau = (i >> 4) & 15, c = i & 15;
        if (d == 0 ? tau > 2 * part + 1 : tau > 15 - 2 * part) continue;
        float sk[16];
#pragma unroll
        for (int c2 = 0; c2 < 16; ++c2) sk[c2] = 0.f;
        for (int p = 0; p < 64; ++p) { const f32x2 C = Cc[c * 64 + p], P = apw[(d * 64 + p) * 17 + tau];
            const float wr = C.x * P.x - C.y * P.y, wi = C.x * P.y + C.y * P.x;
#pragma unroll
            for (int c2 = 0; c2 < 16; c2 += 2) { const f32x4 B2 = *(const LAS f32x4*)(Bt + (d * 64 + p) * 16 + c2); sk[c2] += wr * B2[0] - wi * B2[1]; sk[c2 + 1] += wr * B2[2] - wi * B2[3]; } }
#pragma unroll
        for (int c2 = 0; c2 < 16; ++c2) Kt[i * 16 + c2] = sk[c2];
    }
    __syncthreads();
    bf16_t* BA = (bf16_t*)(F.ws + WS_S5A) + (size_t)job * 256 * 256; bf16_t* BB = (bf16_t*)(F.ws + WS_S5B) + (size_t)job * 256 * 512;
    for (int i = part * 8192 + F.tid; i < (part + 1) * 8192; i += NTHR) {
        const int n = i >> 8, k = i & 255, d = n >> 7, p = (n & 127) >> 1, ri = n & 1, s = k >> 4, c2 = k & 15, e = d == 0 ? 15 - s : s;
        const f32x2 P = apw[(d * 64 + p) * 17 + e], B = Bt[(d * 64 + p) * 16 + c2];
        BA[i] = (bf16_t)f2bf(ri == 0 ? P.x * B.x - P.y * B.y : P.x * B.y + P.y * B.x);
    }
    for (int i = part * 16384 + F.tid; i < (part + 1) * 16384; i += NTHR) {
        const int n = i >> 9, k = i & 511, t = n >> 4, c = n & 15; float v;
        if (k < 256) { const int s = k >> 4, c2 = k & 15; v = 0.f; if (s <= t) v += Kt[((0 * 16 + (t - s)) * 16 + c) * 16 + c2]; if (s >= t) v += Kt[((1 * 16 + (s - t)) * 16 + c) * 16 + c2]; }
        else { const int kk = k - 256, d = kk >> 7, p = (kk & 127) >> 1, ri = kk & 1, e = d == 0 ? t + 1 : 16 - t;
            const f32x2 C = Cc[c * 64 + p], P = apw[(d * 64 + p) * 17 + e]; const float wr = C.x * P.x - C.y * P.y, wi = C.x * P.y + C.y * P.x; v = ri == 0 ? wr : -wi; }
        BB[i] = (bf16_t)f2bf(v);
    }
    __syncthreads();
}
DI int s5_chunk_at(int d, int b, int ci) { return ci < 16 ? 2048 + b * 16 + (d ? 15 - ci : ci) : b * 128 + (d ? 127 - (ci - 16) : ci - 16); }
DI void s5_carry_item(const Frame& F, int li, int idx) {
    const int p = idx & 63, d = (idx >> 6) & 1, g = (idx >> 7) & 15, b = idx >> 11;
    const f32x2 a16 = ((const f32x2*)(F.ws + WS_S5P))[((li * 16 + g) * 2 + d) * 64 + p];
    const unsigned* xl = (const unsigned*)(F.ws + WS_XLOC) + (size_t)g * NCHK * 128 + d * 64 + p;
    unsigned* x0 = (unsigned*)(F.ws + WS_ACAT) + (size_t)g * NCHK * 256 + 128 + d * 64 + p;
    float xr = 0.f, xi = 0.f;
#pragma unroll 1
    for (int blk = 0; blk < 4; ++blk) {
        unsigned v[36];
#pragma unroll
        for (int j = 0; j < 36; ++j) v[j] = xl[(size_t)s5_chunk_at(d, b, blk * 36 + j) * 128];
#pragma unroll
        for (int j = 0; j < 36; ++j) { x0[(size_t)s5_chunk_at(d, b, blk * 36 + j) * 256] = pg8::cvt_pk_nv(xr, xi);
            const float nr = a16.x * xr - a16.y * xi + bflo(v[j]), ni = a16.x * xi + a16.y * xr + bfhi(v[j]); xr = nr; xi = ni; }
    }
}
struct S5Order {
    static constexpr bool GATHER = false; DI const int* row_tab(const pg8::Unit&) const { return nullptr; }
    int G, c; const char* A; const char* B; size_t ga, gb, ta;
    __device__ bool next(int i, pg8::Unit& u) const { const long L = (long)i * G + c; if (L >= 144) return false; u.g = (int)(L / 9); u.pm = (int)(L % 9); u.pn = 0; return true; }
    DI const char* a_ptr(const pg8::Unit& u) const { return A + (size_t)u.g * ga + (size_t)u.pm * ta; }
    DI const char* b_ptr(const pg8::Unit& u) const { return B + (size_t)u.g * gb; }
    DI void a_ready(const pg8::Unit&) const {}
    DI void done(const pg8::Unit&) const {}
};
struct EpiS5A {
    static constexpr bool PERM = true, AFTER_DRAIN = false;
    bf16_t* X;
    DI void operator()(const f32x4 (&acc)[2][2][4][2], const pg8::Unit& u, int wr, int wc, int fr, int fq) const {
#pragma unroll
        for (int ai = 0; ai < 2; ++ai)
#pragma unroll
            for (int m = 0; m < 4; ++m) { const int row = u.pm * 256 + wr * 64 + fr + ai * 128 + m * 16;
#pragma unroll
                for (int bj = 0; bj < 2; ++bj) { const f32x4 v0 = acc[ai][bj][m][0], v1 = acc[ai][bj][m][1];
                    u32x4 w; w.x = pg8::cvt_pk_nv(v0[0], v0[1]); w.y = pg8::cvt_pk_nv(v0[2], v0[3]); w.z = pg8::cvt_pk_nv(v1[0], v1[1]); w.w = pg8::cvt_pk_nv(v1[2], v1[3]);
                    *(u32x4*)(X + ((size_t)u.g * NCHK + row) * 256 + bj * 128 + wc * 32 + 8 * fq) = w; } }
    }
};
DI float gelu_tanh_(float x) { const float t = 0.7978845608028654f * (x + 0.044715f * x * x * x); const float e = __expf(2.0f * t); return x * (1.0f - __builtin_amdgcn_rcpf(e + 1.0f)); }
struct EpiS5B {
    static constexpr bool PERM = true, AFTER_DRAIN = false;
    const bf16_t* Acat; const float* dsk; bf16_t* mix;
    DI void operator()(const f32x4 (&acc)[2][2][4][2], const pg8::Unit& u, int wr, int wc, int fr, int fq) const {
        const int chunk0 = u.pm * 256 + wr * 64 + fr;
        auto ld = [&](int k) { const int bj = k >> 3, ai = (k >> 2) & 1, m = k & 3; return *(const u32x4*)(Acat + ((size_t)u.g * NCHK + chunk0 + ai * 128 + m * 16) * 512 + bj * 128 + wc * 32 + 8 * fq); };
        u32x4 uc = ld(0), un = uc;
#pragma unroll
        for (int k = 0; k < 16; ++k) {
            const int bj = k >> 3, ai = (k >> 2) & 1, m = k & 3;
            if (k < 15) un = ld(k + 1);
            const int cr = bj * 128 + wc * 32 + 8 * fq, t = cr >> 4, c = cr & 15;
            const f32x4 d0 = *(const f32x4*)(dsk + u.g * 16 + c), d1 = *(const f32x4*)(dsk + u.g * 16 + c + 4);
            const int chunk = chunk0 + ai * 128 + m * 16; const u32x4 uw = uc;
            const f32x4 y0 = acc[ai][bj][m][0], y1 = acc[ai][bj][m][1];
            const float v0 = gelu_tanh_(y0[0] + d0[0] * bflo(uw.x)), v1 = gelu_tanh_(y0[1] + d0[1] * bfhi(uw.x)), v2 = gelu_tanh_(y0[2] + d0[2] * bflo(uw.y)), v3 = gelu_tanh_(y0[3] + d0[3] * bfhi(uw.y));
            const float v4 = gelu_tanh_(y1[0] + d1[0] * bflo(uw.z)), v5 = gelu_tanh_(y1[1] + d1[1] * bfhi(uw.z)), v6 = gelu_tanh_(y1[2] + d1[2] * bflo(uw.w)), v7 = gelu_tanh_(y1[3] + d1[3] * bfhi(uw.w));
            u32x4 w; w.x = pg8::cvt_pk_bf16(v0, v1); w.y = pg8::cvt_pk_bf16(v2, v3); w.z = pg8::cvt_pk_bf16(v4, v5); w.w = pg8::cvt_pk_bf16(v6, v7);
            *(u32x4*)(mix + (size_t)(chunk * 16 + t) * D + 256 + u.g * 16 + c) = w;
            uc = un;
        }
    }
};
struct EpiGLU {
    static constexpr bool PERM = true, AFTER_DRAIN = false;
    bf16_t* mix; const float* gb;
    DI void operator()(const f32x4 (&acc)[2][2][4][2], const pg8::Unit& u, int wr, int wc, int fr, int fq) const {
        const int row0 = u.pm * 256 + wr * 64 + fr;
        auto ptr = [&](int k) { const int bj = k >> 3, ai = (k >> 2) & 1, m = k & 3; return mix + (size_t)(row0 + ai * 128 + m * 16) * D + 256 + bj * 128 + wc * 32 + 8 * fq; };
        u32x4 vc = *(const u32x4*)ptr(0), vn = vc;
#pragma unroll
        for (int k = 0; k < 16; ++k) {
            const int bj = k >> 3, ai = (k >> 2) & 1, m = k & 3;
            if (k < 15) vn = *(const u32x4*)ptr(k + 1);
            const int cr = bj * 128 + wc * 32 + 8 * fq; const f32x4 b0 = *(const f32x4*)(gb + cr), b1 = *(const f32x4*)(gb + cr + 4);
            const u32x4 vw = vc; const f32x4 y0 = acc[ai][bj][m][0] + b0, y1 = acc[ai][bj][m][1] + b1;
            u32x4 w; w.x = pg8::cvt_pk_bf16(bflo(vw.x) * sigmoidf_(y0[0]), bfhi(vw.x) * sigmoidf_(y0[1])); w.y = pg8::cvt_pk_bf16(bflo(vw.y) * sigmoidf_(y0[2]), bfhi(vw.y) * sigmoidf_(y0[3]));
            w.z = pg8::cvt_pk_bf16(bflo(vw.z) * sigmoidf_(y1[0]), bfhi(vw.z) * sigmoidf_(y1[1])); w.w = pg8::cvt_pk_bf16(bflo(vw.w) * sigmoidf_(y1[2]), bfhi(vw.w) * sigmoidf_(y1[3]));
            *(u32x4*)ptr(k) = w;
            vc = vn;
        }
    }
};
constexpr float QSCALE = 0.25503486f;
struct EpiInProj {
    static constexpr bool PERM = true, AFTER_DRAIN = false;
    bf16_t* Z; const float* bias; const float* rope; bf16_t* Acat;
    DI void operator()(const f32x4 (&acc)[2][2][4][2], const pg8::Unit& u, int wr, int wc, int fr, int fq) const {
        const int pn = u.pn, row0 = u.pm * 256 + wr * 64 + fr;
        const float scl = (pn == 0 || pn == 10) ? 0.125f : (pn == 6 ? QSCALE : 1.0f);
        const bool do_rope = (pn == 6 || pn == 7) && (u.pm < 128);
        f32x4 bv[2][2];
#pragma unroll
        for (int bj = 0; bj < 2; ++bj) { const int c0 = pn * 256 + bj * 128 + wc * 32 + 8 * fq; bv[bj][0] = *(const f32x4*)(bias + c0); bv[bj][1] = *(const f32x4*)(bias + c0 + 4); }
        auto rp_of = [&](int k) { return rope + ((size_t)((row0 + (k >> 2) * 128 + (k & 3) * 16) & 2047) * 16 + 4 * fq) * 2; };
        f32x4 r0 = {1.f, 0.f, 1.f, 0.f}, r1 = r0, q0 = r0, q1 = r0;
        if (do_rope) { const float* rp = rp_of(0); r0 = *(const f32x4*)rp; r1 = *(const f32x4*)(rp + 4); }
#pragma unroll
        for (int k = 0; k < 8; ++k) {
            const int ai = k >> 2, m = k & 3, row = row0 + ai * 128 + m * 16;
            if (do_rope && k < 7) { const float* rp = rp_of(k + 1); q0 = *(const f32x4*)rp; q1 = *(const f32x4*)(rp + 4); }
#pragma unroll
            for (int bj = 0; bj < 2; ++bj) {
                const int c0 = pn * 256 + bj * 128 + wc * 32 + 8 * fq;
                f32x4 v0 = acc[ai][bj][m][0] + bv[bj][0], v1 = acc[ai][bj][m][1] + bv[bj][1];
                if (do_rope) {
                    f32x4 w0, w1;
                    w0[0] = v0[0] * r0[0] - v0[1] * r0[1]; w0[1] = v0[0] * r0[1] + v0[1] * r0[0];
                    w0[2] = v0[2] * r0[2] - v0[3] * r0[3]; w0[3] = v0[2] * r0[3] + v0[3] * r0[2];
                    w1[0] = v1[0] * r1[0] - v1[1] * r1[1]; w1[1] = v1[0] * r1[1] + v1[1] * r1[0];
                    w1[2] = v1[2] * r1[2] - v1[3] * r1[3]; w1[3] = v1[2] * r1[3] + v1[3] * r1[2];
                    v0 = w0; v1 = w1;
                }
                v0 = v0 * scl; v1 = v1 * scl;
                u32x4 w; w.x = pg8::cvt_pk_bf16(v0[0], v0[1]); w.y = pg8::cvt_pk_bf16(v0[2], v0[3]); w.z = pg8::cvt_pk_bf16(v1[0], v1[1]); w.w = pg8::cvt_pk_bf16(v1[2], v1[3]);
                *(u32x4*)(Z + (size_t)row * ZC + c0) = w;
                if (pn == 5) { const int cr = bj * 128 + wc * 32 + 8 * fq; *(u32x4*)(Acat + ((size_t)(cr >> 4) * (NTOK / 16) + (row >> 4)) * 512 + (row & 15) * 16 + (cr & 15)) = w; }
            }
            r0 = q0; r1 = q1;
        }
    }
};
struct EpiOutProj {
    static constexpr bool PERM = true, AFTER_DRAIN = false;
    const float* res_lat; const float* res_ctx; const bf16_t* res_bf; bf16_t* out; const float* modg;
    DI void operator()(const f32x4 (&acc)[2][2][4][2], const pg8::Unit& u, int wr, int wc, int fr, int fq) const {
        const int row0 = u.pm * 256 + wr * 64 + fr, col0 = u.pn * 256 + wc * 32 + 8 * fq;
        const int s = (u.pm < 128) ? (u.pm >> 3) : 16;
        f32x4 gv[2][2];
#pragma unroll
        for (int bj = 0; bj < 2; ++bj)
#pragma unroll
            for (int n = 0; n < 2; ++n) gv[bj][n] = *(const f32x4*)(modg + (size_t)s * 6144 + col0 + bj * 128 + 4 * n);
        if (res_bf) {
            u32x4 rc[2], rn[2];
#pragma unroll
            for (int bj = 0; bj < 2; ++bj) rc[bj] = *(const u32x4*)(res_bf + (size_t)row0 * D + col0 + bj * 128);
#pragma unroll
            for (int k = 0; k < 8; ++k) {
                const int row = row0 + (k >> 2) * 128 + (k & 3) * 16;
                if (k < 7) { const int rnx = row0 + ((k + 1) >> 2) * 128 + ((k + 1) & 3) * 16;
#pragma unroll
                    for (int bj = 0; bj < 2; ++bj) rn[bj] = *(const u32x4*)(res_bf + (size_t)rnx * D + col0 + bj * 128); }
#pragma unroll
                for (int bj = 0; bj < 2; ++bj) { const u32x4 w0 = rc[bj];
                    const f32x4 r0 = (f32x4){bflo(w0.x), bfhi(w0.x), bflo(w0.y), bfhi(w0.y)}, r1 = (f32x4){bflo(w0.z), bfhi(w0.z), bflo(w0.w), bfhi(w0.w)};
                    const f32x4 v0 = r0 + gv[bj][0] * acc[k >> 2][bj][k & 3][0], v1 = r1 + gv[bj][1] * acc[k >> 2][bj][k & 3][1];
                    u32x4 w; w.x = pg8::cvt_pk_bf16(v0[0], v0[1]); w.y = pg8::cvt_pk_bf16(v0[2], v0[3]); w.z = pg8::cvt_pk_bf16(v1[0], v1[1]); w.w = pg8::cvt_pk_bf16(v1[2], v1[3]);
                    *(u32x4*)(out + (size_t)row * D + col0 + bj * 128) = w; }
                rc[0] = rn[0]; rc[1] = rn[1];
            }
            return;
        }
        const float* rbase = (u.pm < 128) ? res_lat + (size_t)row0 * D + col0 : res_ctx + (size_t)(row0 - NLAT) * D + col0;
        auto off = [&](int q) { return (size_t)((q >> 3) * 128 + ((q >> 1) & 3) * 16) * D + (q & 1) * 128; };
        f32x4 c0 = *(const f32x4*)(rbase), c1 = *(const f32x4*)(rbase + 4), n0 = c0, n1 = c1;
#pragma unroll
        for (int q = 0; q < 16; ++q) {
            const int ai = q >> 3, m = (q >> 1) & 3, bj = q & 1, row = row0 + ai * 128 + m * 16, c = col0 + bj * 128;
            if (q < 15) { const float* rp = rbase + off(q + 1); n0 = *(const f32x4*)rp; n1 = *(const f32x4*)(rp + 4); }
            const f32x4 v0 = c0 + gv[bj][0] * acc[ai][bj][m][0], v1 = c1 + gv[bj][1] * acc[ai][bj][m][1];
            u32x4 w; w.x = pg8::cvt_pk_bf16(v0[0], v0[1]); w.y = pg8::cvt_pk_bf16(v0[2], v0[3]); w.z = pg8::cvt_pk_bf16(v1[0], v1[1]); w.w = pg8::cvt_pk_bf16(v1[2], v1[3]);
            *(u32x4*)(out + (size_t)row * D + c) = w;
            c0 = n0; c1 = n1;
        }
    }
};
struct EpiSwiGLU {
    static constexpr bool PERM = true, AFTER_DRAIN = false;
    bf16_t* H; int MT;
    DI void operator()(const f32x4 (&acc)[2][2][4][2], const pg8::Unit& u, int wr, int wc, int fr, int fq) const {
        const int row0 = (u.g * MT + u.pm) * 256 + wr * 64 + fr, col = u.pn * 128 + wc * 32 + 8 * fq;
#pragma unroll
        for (int ai = 0; ai < 2; ++ai)
#pragma unroll
            for (int m = 0; m < 4; ++m) {
                const int row = row0 + ai * 128 + m * 16;
                float h[8];
#pragma unroll
                for (int n = 0; n < 2; ++n)
#pragma unroll
                    for (int j = 0; j < 4; ++j) { const float a = acc[ai][0][m][n][j], b = acc[ai][1][m][n][j]; h[n * 4 + j] = a * __builtin_amdgcn_rcpf(1.0f + __expf(-a)) * b; }
                u32x4 w; w.x = pg8::cvt_pk_bf16(h[0], h[1]); w.y = pg8::cvt_pk_bf16(h[2], h[3]); w.z = pg8::cvt_pk_bf16(h[4], h[5]); w.w = pg8::cvt_pk_bf16(h[6], h[7]);
                *(u32x4*)(H + (size_t)row * DE + col) = w;
            }
    }
};
struct EpiDown {
    static constexpr bool PERM = true, AFTER_DRAIN = false;
    bf16_t* Y; const float* gate; int MT;
    DI void operator()(const f32x4 (&acc)[2][2][4][2], const pg8::Unit& u, int wr, int wc, int fr, int fq) const {
        const int row0 = (u.g * MT + u.pm) * 256 + wr * 64 + fr, col0 = u.pn * 256 + wc * 32 + 8 * fq;
        float gtv[8];
#pragma unroll
        for (int k = 0; k < 8; ++k) gtv[k] = gate[row0 + (k >> 2) * 128 + (k & 3) * 16];
#pragma unroll
        for (int ai = 0; ai < 2; ++ai)
#pragma unroll
            for (int m = 0; m < 4; ++m) {
                const int row = row0 + ai * 128 + m * 16; const float gt = gtv[ai * 4 + m];
#pragma unroll
                for (int bj = 0; bj < 2; ++bj) {
                    const f32x4 v0 = acc[ai][bj][m][0] * gt, v1 = acc[ai][bj][m][1] * gt;
                    u32x4 w; w.x = pg8::cvt_pk_bf16(v0[0], v0[1]); w.y = pg8::cvt_pk_bf16(v0[2], v0[3]); w.z = pg8::cvt_pk_bf16(v1[0], v1[1]); w.w = pg8::cvt_pk_bf16(v1[2], v1[3]);
                    *(u32x4*)(Y + (size_t)row * D + col0 + bj * 128) = w;
                }
            }
    }
};
DI void transpose_item(const float* W, int ldw, int k0, int n0, bf16_t* WT, size_t drow0, int ldk, LAS float* scr, int lane) {
    float tv[32];
#pragma unroll
    for (int i = 0; i < 32; ++i) tv[i] = W[(size_t)(k0 + 2 * i + (lane >> 5)) * ldw + n0 + (lane & 31)];
#pragma unroll
    for (int i = 0; i < 32; ++i) scr[(2 * i + (lane >> 5)) * 33 + (lane & 31)] = tv[i];
    LDS_WAIT();
    const int c = lane & 7;
#pragma unroll
    for (int j = 0; j < 4; ++j) { const int n = (lane >> 3) + 8 * j; const LAS float* s = scr + (8 * c) * 33 + n;
        u32x4 o; o.x = pg8::cvt_pk_nv(s[0 * 33], s[1 * 33]); o.y = pg8::cvt_pk_nv(s[2 * 33], s[3 * 33]); o.z = pg8::cvt_pk_nv(s[4 * 33], s[5 * 33]); o.w = pg8::cvt_pk_nv(s[6 * 33], s[7 * 33]);
        *(u32x4*)(WT + (drow0 + n) * (size_t)ldk + k0 + 8 * c) = o; }
    LDS_WAIT();
}
constexpr int IT_WIN = 16 * 104, IT_WOUT = 16 * 32, IT_EXP = 3072, IT_GLU = 32;
DI void dense_weight_item(const Frame& F, int it, LAS float* scr) {
    if (it < 2 * IT_WIN) { const int li = it / IT_WIN, r = it % IT_WIN, kb = r / 104, nb = r % 104;
        transpose_item(F.in[I_WIN] + (size_t)li * D * INC, INC, 64 * kb, 32 * nb, (bf16_t*)(F.ws + WS_WIN) + (size_t)li * ZC * D, 32 * nb, D, scr, F.lane); return; }
    it -= 2 * IT_WIN;
    if (it < 2 * IT_WOUT) { const int li = it / IT_WOUT, r = it % IT_WOUT, kb = r / 32, nb = r % 32;
        transpose_item(F.in[I_WOUT] + (size_t)li * D * D, D, 64 * kb, 32 * nb, (bf16_t*)(F.ws + WS_WOUT) + (size_t)li * D * D, 32 * nb, D, scr, F.lane); return; }
    it -= 2 * IT_WOUT;
    { const int li = it / IT_GLU, r = it % IT_GLU, kb = r / 8, nb = r % 8;
        transpose_item(F.in[I_S5GW] + (size_t)li * 256 * 256, 256, 64 * kb, 32 * nb, (bf16_t*)(F.ws + WS_GLUW) + (size_t)li * 256 * 256, 32 * nb, 256, scr, F.lane); }
}
DI void expert_weight_item(const Frame& F, int le, int it, LAS float* scr) {
    const int e = it / IT_EXP; int r = it % IT_EXP;
    if (r < 2048) { const int w3 = r >= 1024; r &= 1023; const int kb = r / 64, nb = r % 64, n0 = 32 * nb;
        transpose_item(F.in[w3 ? I_W3 : I_W1] + (size_t)(le * NE + e) * D * DE, DE, 64 * kb, n0, (bf16_t*)(F.ws + WS_W13) + (size_t)e * 4096 * D, (size_t)(n0 >> 7) * 256 + (n0 & 127) + (w3 ? 128 : 0), D, scr, F.lane); return; }
    r -= 2048; { const int kb = r / 32, nb = r % 32;
        transpose_item(F.in[I_W2] + (size_t)(le * NE + e) * DE * D, D, 64 * kb, 32 * nb, (bf16_t*)(F.ws + WS_W2) + (size_t)e * D * DE, 32 * nb, DE, scr, F.lane); }
}

DI void phase_prologue(const Frame& F) {
    LAS float* sc = (LAS float*)F.lds;
    LAS float* scr = (LAS float*)(F.lds + 69632) + F.wave * (64 * 33);
    for (int job = F.bid; job < 256; job += F.G) s5_tables_job(F, job);
    __syncthreads();
    for (int i = F.tid; i < 17 * 1024; i += NTHR) { const float v = i < 16 * 1024 ? F.in[I_C][i] : F.in[I_CCTX][i - 16 * 1024]; sc[i] = siluf_(v); }
    __syncthreads();
    for (int job = F.bid; job < 192; job += F.G) {
        const int li = job / 96, n = (job % 96) * 64 + F.lane;
        const float* mw = F.in[I_MODW] + (size_t)li * D * 6144 + n;
        LAS float* red = (LAS float*)(F.lds + 69632);
        float acc[17];
#pragma unroll
        for (int s = 0; s < 17; ++s) acc[s] = 0.f;
        for (int k = 128 * F.wave; k < 128 * F.wave + 128; k += 16) {
            float w[16];
#pragma unroll
            for (int j = 0; j < 16; ++j) w[j] = mw[(size_t)(k + j) * 6144];
#pragma unroll
            for (int s = 0; s < 17; ++s) {
#pragma unroll
                for (int q = 0; q < 4; ++q) { const f32x4 c0 = *(const LAS f32x4*)(sc + s * 1024 + k + 4 * q); acc[s] += (c0[0] * w[4 * q] + c0[1] * w[4 * q + 1]) + (c0[2] * w[4 * q + 2] + c0[3] * w[4 * q + 3]); } }
        }
#pragma unroll
        for (int s = 0; s < 17; ++s) red[(F.wave * 17 + s) * 64 + F.lane] = acc[s];
        __syncthreads();
        for (int o = F.tid; o < 17 * 64; o += NTHR) { float v = 0.f;
#pragma unroll
            for (int w8 = 0; w8 < 8; ++w8) v += red[w8 * 17 * 64 + o];
            const int s = o >> 6, nn = (job % 96) * 64 + (o & 63);
            ((float*)(F.ws + WS_MOD))[((size_t)li * 17 + s) * 6144 + nn] = v + F.in[I_MODB][li * 6144 + nn]; }
        __syncthreads();
    }
    if (F.wave == 7) {
      for (int job = 192 + F.bid; job < 257; job += F.G) {
        if (job < 256) {
            float* rp = (float*)(F.ws + WS_ROPE);
            for (int i = 0; i < 8; ++i) { const int e = (job - 192) * 512 + F.lane + 64 * i; const int t = e >> 4, j = e & 15;
                const float pos = (float)(j < 8 ? (t >> 6) : (t & 63)), inv = expf(-9.210340371976184f * (float)(j & 7) * 0.125f), ang = pos * inv;
                rp[2 * e] = cosf(ang); rp[2 * e + 1] = sinf(ang); }
        } else {
            float* lb = (float*)(F.ws + WS_LB); const float* lg = F.in[I_HGLB];
            for (int i = F.lane; i < 1024; i += 64) { const int li = i >> 9, r = i & 511; lb[i] = li == 0 ? 0.f : sigmoidf_(lg[512 + r] - lg[r]); }
        }
      }
    }
    const int gw = F.bid * NWAVES + F.wave, NGW = F.G * NWAVES;
    for (int it = gw; it < 2 * IT_WIN + 2 * IT_WOUT + 2 * IT_GLU; it += NGW) dense_weight_item(F, it, scr);
    for (int it = gw; it < NE * IT_EXP; it += NGW) expert_weight_item(F, 0, it, scr);
}

DI void moe_combine(const Frame& F, int row, int MT, f32x4 (&acc)[4]) {
    const int s = row < NLAT ? (row >> 11) : 16 + ((row - NLAT) >> 8), t = row < NLAT ? (row & 2047) : ((row - NLAT) & 255);
    const int* inv = (const int*)(F.ws + WS_INV) + (size_t)s * 16 * 2048 + t;
    const bf16_t* Y = (const bf16_t*)(F.ws + WS_XS);
#pragma unroll
    for (int j = 0; j < 4; ++j) acc[j] = (f32x4){0.f, 0.f, 0.f, 0.f};
    const int jl = inv[(F.lane & 15) * 2048];
    unsigned hits = (unsigned)(__ballot(jl >= 0) & 0xffffull);
    while (hits) {
        const int e0 = __builtin_ctz(hits); hits &= hits - 1;
        const bool two = hits != 0u; const int e1 = two ? __builtin_ctz(hits) : e0; if (two) hits &= hits - 1;
        const bf16_t* y0 = Y + (size_t)xs_row(e0, s, __builtin_amdgcn_readlane(jl, e0), MT) * D + 4 * F.lane;
        const bf16_t* y1 = Y + (size_t)xs_row(e1, s, __builtin_amdgcn_readlane(jl, e1), MT) * D + 4 * F.lane;
        u32x2 w0[4], w1[4];
#pragma unroll
        for (int j = 0; j < 4; ++j) { w0[j] = *(const u32x2*)(y0 + 256 * j); w1[j] = *(const u32x2*)(y1 + 256 * j); }
#pragma unroll
        for (int j = 0; j < 4; ++j) { acc[j][0] += bflo(w0[j].x); acc[j][1] += bfhi(w0[j].x); acc[j][2] += bflo(w0[j].y); acc[j][3] += bfhi(w0[j].y); }
        if (two) {
#pragma unroll
            for (int j = 0; j < 4; ++j) { acc[j][0] += bflo(w1[j].x); acc[j][1] += bfhi(w1[j].x); acc[j][2] += bflo(w1[j].y); acc[j][3] += bfhi(w1[j].y); } }
    }
}

template <int KIND> DI void phase_norm(const Frame& F, int li) {
    LAS float* WT = (LAS float*)F.lds;
    if (KIND != 2) {
        for (int i = F.tid; i < 16 * 1024; i += NTHR) { const int k = i >> 4, jj = i & 15;
            WT[((jj >> 1) * 1024 + k) * 2 + (jj & 1)] = KIND == 0 ? F.in[I_WIN][((size_t)li * D + k) * INC + ZC + jj] : F.in[I_RTW][((size_t)li * D + k) * 16 + jj]; }
        __syncthreads();
    }
    const int gw = F.bid * NWAVES + F.wave, NGW = F.G * NWAVES;
    const int nrows = (KIND == 0 || li == 0) && KIND != 2 ? NTOK : NLAT;
    const float* modl = (const float*)(F.ws + WS_MOD) + (size_t)li * 17 * 6144;
    bf16_t* hl = (bf16_t*)(F.ws + WS_HL);
    bf16_t* xn = (bf16_t*)(F.ws + WS_XN);
    const float* nw = KIND == 0 ? F.in[I_N1W] + li * D : (KIND == 1 ? F.in[I_N2W] + li * D : F.in[I_FNW]);
    f32x4 vn[4];
    auto load_row = [&](int row) {
        if (KIND == 0 && li == 0) { const float* src = row < NLAT ? F.in[I_X] + (size_t)row * D : F.in[I_CTX] + (size_t)(row - NLAT) * D;
#pragma unroll
            for (int j = 0; j < 4; ++j) vn[j] = *(const f32x4*)(src + 4 * F.lane + 256 * j);
        } else {
#pragma unroll
            for (int j = 0; j < 4; ++j) { const u32x2 w = *(const u32x2*)(hl + (size_t)row * D + 4 * F.lane + 256 * j); vn[j] = (f32x4){bflo(w.x), bfhi(w.x), bflo(w.y), bfhi(w.y)}; }
        }
    };
    f32x4 nwv[4];
#pragma unroll
    for (int j = 0; j < 4; ++j) nwv[j] = *(const f32x4*)(nw + 4 * F.lane + 256 * j);
    if (gw < nrows) load_row(gw);
    for (int row = gw; row < nrows; row += NGW) {
        const int s = mod_idx(row);
        f32x4 v[4];
#pragma unroll
        for (int j = 0; j < 4; ++j) v[j] = vn[j];
        if (row + NGW < nrows) load_row(row + NGW);
        f32x4 scv[4], shv[4];
        if (KIND != 2) { const float* sh_ = modl + (size_t)s * 6144 + (KIND == 0 ? 0 : 3) * 1024;
#pragma unroll
            for (int j = 0; j < 4; ++j) { shv[j] = *(const f32x4*)(sh_ + 4 * F.lane + 256 * j); scv[j] = *(const f32x4*)(sh_ + 1024 + 4 * F.lane + 256 * j); } }
        if (KIND == 2 || (KIND == 0 && li > 0)) {
            const int lm = KIND == 2 ? DEPTH - 1 : li - 1; const float* g5 = (const float*)(F.ws + WS_MOD) + ((size_t)lm * 17 + s) * 6144 + 5 * 1024;
            f32x4 a[4]; moe_combine(F, row, lm == 0 ? 18 : 16, a);
#pragma unroll
            for (int j = 0; j < 4; ++j) { v[j] = v[j] + *(const f32x4*)(g5 + 4 * F.lane + 256 * j) * a[j]; if (KIND == 0) { u32x2 w; w.x = pg8::cvt_pk_bf16(v[j][0], v[j][1]); w.y = pg8::cvt_pk_bf16(v[j][2], v[j][3]); *(u32x2*)(hl + (size_t)row * D + 4 * F.lane + 256 * j) = w; } }
        }
        float ss = 0.f;
#pragma unroll
        for (int j = 0; j < 4; ++j) ss += (v[j][0] * v[j][0] + v[j][1] * v[j][1]) + (v[j][2] * v[j][2] + v[j][3] * v[j][3]);
        const float rstd = rsqrtf(wave_sum(ss) * (1.0f / D) + EPS);
        if (KIND == 2) {
#pragma unroll
            for (int j = 0; j < 4; ++j) *(f32x4*)(F.out + (size_t)row * D + 4 * F.lane + 256 * j) = v[j] * rstd * nwv[j];
            continue;
        }
        f32x2 p2[8];
#pragma unroll
        for (int jp = 0; jp < 8; ++jp) p2[jp] = (f32x2){0.f, 0.f};
#pragma unroll
        for (int j = 0; j < 4; ++j) {
            const int k = 4 * F.lane + 256 * j;
            const f32x4 y = v[j] * rstd * nwv[j] * (scv[j] + 1.0f) + shv[j];
            u32x2 w; w.x = pg8::cvt_pk_bf16(y[0], y[1]); w.y = pg8::cvt_pk_bf16(y[2], y[3]);
            *(u32x2*)(xn + (size_t)row * D + k) = w;
            f32x4 wa[8], wb[8];
#pragma unroll
            for (int jp = 0; jp < 8; ++jp) { wa[jp] = *(const LAS f32x4*)(WT + (jp * 1024 + k) * 2); wb[jp] = *(const LAS f32x4*)(WT + (jp * 1024 + k) * 2 + 4); }
            __builtin_amdgcn_sched_barrier(0);
#pragma unroll
            for (int jp = 0; jp < 8; ++jp) {
                p2[jp] = p2[jp] + (f32x2){y[0], y[0]} * (f32x2){wa[jp][0], wa[jp][1]}; p2[jp] = p2[jp] + (f32x2){y[1], y[1]} * (f32x2){wa[jp][2], wa[jp][3]};
                p2[jp] = p2[jp] + (f32x2){y[2], y[2]} * (f32x2){wb[jp][0], wb[jp][1]}; p2[jp] = p2[jp] + (f32x2){y[3], y[3]} * (f32x2){wb[jp][2], wb[jp][3]}; }
        }
        float p[16];
#pragma unroll
        for (int jp = 0; jp < 8; ++jp) { p[2 * jp] = p2[jp][0]; p[2 * jp + 1] = p2[jp][1]; }
        const float r = reduce16(p, F.lane); const int o = F.lane >> 2;
        if (KIND == 0) { if ((F.lane & 3) == 0) ((float*)(F.ws + WS_ZG))[(size_t)row * 16 + o] = r + F.in[I_BIN][li * INC + ZC + o]; }
        else {
            float mx = r;
            mx = fmaxf(mx, dpp_perm(mx, 2)); mx = fmaxf(mx, dpp_perm(mx, 3));
            mx = fmaxf(fmaxf(row_lane(mx, 0), row_lane(mx, 16)), fmaxf(row_lane(mx, 32), row_lane(mx, 48)));
            const float ex = __expf(r - mx); float sm = ex;
            sm += dpp_perm(sm, 2); sm += dpp_perm(sm, 3);
            sm = (row_lane(sm, 0) + row_lane(sm, 16)) + (row_lane(sm, 32) + row_lane(sm, 48));
            const int sq = row < NLAT ? (row >> 11) : 16 + ((row - NLAT) >> 8), t = row < NLAT ? (row & 2047) : ((row - NLAT) & 255);
            if ((F.lane & 3) == 0) ((float*)(F.ws + WS_AFF))[((size_t)sq * 16 + o) * 2048 + t] = ex / sm;
        }
    }
}
DI float da_lambda(const Frame& F, int li, float& lam_init) {
    float s1 = 0.f, s2 = 0.f;
    for (int i = 0; i < 32; ++i) { s1 += F.in[I_LQ1][li * 32 + i] * F.in[I_LK1][li * 32 + i]; s2 += F.in[I_LQ2][li * 32 + i] * F.in[I_LK2][li * 32 + i]; }
    lam_init = li == 0 ? 0.2f : 0.35550907f;
    return expf(s1) - expf(s2) + lam_init;
}
constexpr int AT_RS = 144;
constexpr int AT_TILE = 64 * AT_RS;
DI void attn_unit(const Frame& F, int li, int unit, float lam, float lam_init) {
    const bool isctx = unit >= 512; const int uu = isctx ? unit - 512 : unit;
    const int b = isctx ? uu >> 2 : uu >> 5, h = isctx ? uu & 3 : (uu >> 3) & 3, qb = isctx ? 0 : uu & 7;
    const int fr = F.lane & 15, quad = F.lane >> 4;
    const int qrow0 = (isctx ? NLAT + b * NC : b * NL + qb * 256) + F.wave * 32;
    const int nkt = isctx ? 4 : 36;
    const bf16_t* Z = (const bf16_t*)(F.ws + WS_Z);
    bf16x8 qf[2][2];
#pragma unroll
    for (int qt = 0; qt < 2; ++qt)
#pragma unroll
        for (int m = 0; m < 2; ++m) qf[qt][m] = *(const bf16x8*)(Z + (size_t)(qrow0 + 16 * qt + fr) * ZC + Z_DAQ + h * 64 + m * 32 + 8 * quad);
    f32x4 O[4][2][2], LS[2][2];
#pragma unroll
    for (int dt = 0; dt < 4; ++dt)
#pragma unroll
        for (int qt = 0; qt < 2; ++qt)
#pragma unroll
            for (int m = 0; m < 2; ++m) O[dt][qt][m] = (f32x4){0.f, 0.f, 0.f, 0.f};
#pragma unroll
    for (int qt = 0; qt < 2; ++qt)
#pragma unroll
        for (int m = 0; m < 2; ++m) LS[qt][m] = (f32x4){0.f, 0.f, 0.f, 0.f};
    const bf16x8 ones = __builtin_bit_cast(bf16x8, (u32x4){0x3F803F80u, 0x3F803F80u, 0x3F803F80u, 0x3F803F80u});
    const int skey = F.tid >> 3, spiece = F.tid & 7;
    u32x4 kregA, vregA, kregB, vregB;
    auto load_tile = [&](int t, u32x4& kreg, u32x4& vreg) {
        const int kidx = t * 64 + skey; const int krow = kidx < NC ? NLAT + b * NC + kidx : b * NL + (kidx - NC);
        const bf16_t* zr = Z + (size_t)krow * ZC + h * 64 + spiece * 8;
        kreg = *(const u32x4*)(zr + Z_DAK); vreg = *(const u32x4*)(zr + Z_DAV);
    };
    auto store_tile = [&](int buf, const u32x4& kreg, const u32x4& vreg) {
        LAS unsigned char* kb = F.lds + buf * (2 * AT_TILE); LAS unsigned char* vb = kb + AT_TILE;
        *(LAS u32x4*)(kb + skey * AT_RS + spiece * 16) = kreg;
        const unsigned w[4] = {vreg.x, vreg.y, vreg.z, vreg.w};
        const int kro = ((skey + 4 * spiece) & 63) * 2;
#pragma unroll
        for (int i = 0; i < 4; ++i) { *(LAS unsigned short*)(vb + (spiece * 8 + 2 * i) * AT_RS + kro) = (unsigned short)(w[i] & 0xffffu); *(LAS unsigned short*)(vb + (spiece * 8 + 2 * i + 1) * AT_RS + kro) = (unsigned short)(w[i] >> 16); }
    };
    __syncthreads();
    { u32x4 k0, v0, k1, v1; load_tile(0, k0, v0); load_tile(1, k1, v1); load_tile(2, kregA, vregA); load_tile(3, kregB, vregB); store_tile(0, k0, v0); store_tile(1, k1, v1); }
    __syncthreads();
    f32x4 Sc0, Sc1; u32x4 Pp = (u32x4){0u, 0u, 0u, 0u};
    bf16x8 kfr[2], vf[4];
#pragma unroll
    for (int dt = 0; dt < 4; ++dt) vf[dt] = __builtin_bit_cast(bf16x8, (u32x4){0u, 0u, 0u, 0u});
    { const f32x4 z4 = {0.f, 0.f, 0.f, 0.f};
      kfr[0] = *(const LAS bf16x8*)(F.lds + (fr) * AT_RS + quad * 16); kfr[1] = *(const LAS bf16x8*)(F.lds + (16 + fr) * AT_RS + quad * 16);
      Sc0 = __builtin_amdgcn_mfma_f32_16x16x32_bf16(kfr[0], qf[0][0], z4, 0, 0, 0); Sc1 = __builtin_amdgcn_mfma_f32_16x16x32_bf16(kfr[1], qf[0][0], z4, 0, 0, 0); }
    auto load_v = [&](int j, int g, bf16x8 (&vf)[4]) {
        const LAS unsigned char* vb = F.lds + j * (2 * AT_TILE) + AT_TILE;
#pragma unroll
        for (int dt = 0; dt < 4; ++dt) { const int dvr = 16 * dt + fr, rot = 4 * (dvr >> 3); const LAS unsigned char* vrow = vb + dvr * AT_RS;
            const u32x2 lo = *(const LAS u32x2*)(vrow + ((32 * g + 4 * quad + rot) & 63) * 2), hi = *(const LAS u32x2*)(vrow + ((32 * g + 16 + 4 * quad + rot) & 63) * 2);
            vf[dt] = __builtin_bit_cast(bf16x8, (u32x4){lo.x, lo.y, hi.x, hi.y}); }
    };
#define AT_STEP(J, C) do { \
        constexpr int g_ = (C) >> 2, m_ = ((C) >> 1) & 1, qt_ = (C) & 1; (void)g_; (void)m_; \
        constexpr int pc_ = ((C) + 7) & 7, pm_ = (pc_ >> 1) & 1, pqt_ = pc_ & 1; \
        constexpr int nc_ = ((C) + 1) & 7, ng_ = nc_ >> 2, nm_ = (nc_ >> 1) & 1, nqt_ = nc_ & 1; (void)ng_; \
        const bf16x8 pp_ = __builtin_bit_cast(bf16x8, Pp); \
        float p_[8]; \
        p_[0] = __builtin_amdgcn_exp2f(Sc0[0]); p_[1] = __builtin_amdgcn_exp2f(Sc0[1]); \
        LS[pqt_][pm_] = __builtin_amdgcn_mfma_f32_16x16x32_bf16(ones, pp_, LS[pqt_][pm_], 0, 0, 0); \
        p_[2] = __builtin_amdgcn_exp2f(Sc0[2]); p_[3] = __builtin_amdgcn_exp2f(Sc0[3]); \
        O[0][pqt_][pm_] = __builtin_amdgcn_mfma_f32_16x16x32_bf16(vf[0], pp_, O[0][pqt_][pm_], 0, 0, 0); \
        p_[4] = __builtin_amdgcn_exp2f(Sc1[0]); p_[5] = __builtin_amdgcn_exp2f(Sc1[1]); \
        O[1][pqt_][pm_] = __builtin_amdgcn_mfma_f32_16x16x32_bf16(vf[1], pp_, O[1][pqt_][pm_], 0, 0, 0); \
        p_[6] = __builtin_amdgcn_exp2f(Sc1[2]); p_[7] = __builtin_amdgcn_exp2f(Sc1[3]); \
        O[2][pqt_][pm_] = __builtin_amdgcn_mfma_f32_16x16x32_bf16(vf[2], pp_, O[2][pqt_][pm_], 0, 0, 0); \
        u32x4 w_; w_.x = pg8::cvt_pk_nv(p_[0], p_[1]); w_.y = pg8::cvt_pk_nv(p_[2], p_[3]); \
        O[3][pqt_][pm_] = __builtin_amdgcn_mfma_f32_16x16x32_bf16(vf[3], pp_, O[3][pqt_][pm_], 0, 0, 0); \
        w_.z = pg8::cvt_pk_nv(p_[4], p_[5]); w_.w = pg8::cvt_pk_nv(p_[6], p_[7]); \
        if ((C) == 0) load_v((J), 0, vf); \
        if ((C) == 4) load_v((J), 1, vf); \
        { const f32x4 z4_ = {0.f, 0.f, 0.f, 0.f}; \
          Sc0 = __builtin_amdgcn_mfma_f32_16x16x32_bf16(kfr[0], qf[nqt_][nm_], z4_, 0, 0, 0); Sc1 = __builtin_amdgcn_mfma_f32_16x16x32_bf16(kfr[1], qf[nqt_][nm_], z4_, 0, 0, 0); } \
        if (qt_ == 0) { constexpr int c2_ = ((C) + 2) & 7, g2_ = c2_ >> 2, m2_ = (c2_ >> 1) & 1, j2_ = (C) == 6 ? ((J) + 1) & 3 : (J);     \
            const LAS unsigned char* kbn = F.lds + j2_ * (2 * AT_TILE); \
            kfr[0] = *(const LAS bf16x8*)(kbn + (16 * (2 * g2_) + fr) * AT_RS + m2_ * 64 + quad * 16); kfr[1] = *(const LAS bf16x8*)(kbn + (16 * (2 * g2_ + 1) + fr) * AT_RS + m2_ * 64 + quad * 16); } \
        Pp = w_; __builtin_amdgcn_sched_barrier(0); \
    } while (0)
#define AT_TILE_STEPS(J) do { AT_STEP(J, 0); AT_STEP(J, 1); AT_STEP(J, 2); AT_STEP(J, 3); AT_STEP(J, 4); AT_STEP(J, 5); AT_STEP(J, 6); AT_STEP(J, 7); } while (0)
    for (int t = 0; t < nkt; t += 4) {
        if (t + 2 < nkt) store_tile(2, kregA, vregA);
        if (t + 4 < nkt) load_tile(t + 4, kregA, vregA);
        AT_TILE_STEPS(0);
        __syncthreads();
        if (t + 3 < nkt) store_tile(3, kregB, vregB);
        if (t + 5 < nkt) load_tile(t + 5, kregB, vregB);
        AT_TILE_STEPS(1);
        __syncthreads();
        if (t + 4 < nkt) store_tile(0, kregA, vregA);
        if (t + 6 < nkt) load_tile(t + 6, kregA, vregA);
        AT_TILE_STEPS(2);
        __syncthreads();
        if (t + 5 < nkt) store_tile(1, kregB, vregB);
        if (t + 7 < nkt) load_tile(t + 7, kregB, vregB);
        AT_TILE_STEPS(3);
        __syncthreads();
    }
    { const bf16x8 pp_ = __builtin_bit_cast(bf16x8, Pp);
      LS[1][1] = __builtin_amdgcn_mfma_f32_16x16x32_bf16(ones, pp_, LS[1][1], 0, 0, 0);
#pragma unroll
      for (int dt = 0; dt < 4; ++dt) O[dt][1][1] = __builtin_amdgcn_mfma_f32_16x16x32_bf16(vf[dt], pp_, O[dt][1][1], 0, 0, 0); }
#undef AT_STEP
#undef AT_TILE_STEPS
    const float* nw = F.in[I_DANW] + li * 256 + h * 64; bf16_t* mix = (bf16_t*)(F.ws + WS_MIX);
#pragma unroll
    for (int qt = 0; qt < 2; ++qt) {
        const float l0 = LS[qt][0][0], l1 = LS[qt][1][0];
        const float i0 = 1.0f / l0, i1 = lam / l1;
        f32x4 o[4]; float ss = 0.f;
#pragma unroll
        for (int dt = 0; dt < 4; ++dt) { o[dt] = O[dt][qt][0] * i0 - O[dt][qt][1] * i1; ss += (o[dt][0] * o[dt][0] + o[dt][1] * o[dt][1]) + (o[dt][2] * o[dt][2] + o[dt][3] * o[dt][3]); }
        ss += __shfl_xor(ss, 16); ss += __shfl_xor(ss, 32);
        const float rs = rsqrtf(ss * (1.0f / 64.0f) + EPS) * (1.0f - lam_init);
        bf16_t* mo = mix + (size_t)(qrow0 + 16 * qt + fr) * D + 512 + h * 64 + 4 * quad;
#pragma unroll
        for (int dt = 0; dt < 4; ++dt) { const f32x4 w4 = *(const f32x4*)(nw + 16 * dt + 4 * quad); u32x2 w; w.x = pg8::cvt_pk_bf16(o[dt][0] * rs * w4[0], o[dt][1] * rs * w4[1]); w.y = pg8::cvt_pk_bf16(o[dt][2] * rs * w4[2], o[dt][3] * rs * w4[3]);
            *(u32x2*)(mo + 16 * dt) = w; }
    }
}
constexpr size_t WS_SLOC_HG = WS_T0, WS_SLOC_ML = WS_T1;
constexpr size_t WS_SBF_HG = WS_XN, WS_SBF_ML = WS_XN + 36 * MiB;
constexpr size_t WS_HGP = 32 * MiB;
constexpr size_t WS_MLP = 34 * MiB;
constexpr size_t WS_MLN = 35 * MiB;
constexpr int CH_RS = 80;
DI int chunk_row0(int b, int tc) { return tc < 4 ? NLAT + b * NC + 64 * tc : b * NL + 64 * (tc - 4); }
DI int dir_chunk(int d, int c) { return d == 0 ? c : (c < 4 ? 3 - c : 39 - c); }
DI float logsigmoidf_(float x) { return fminf(x, 0.f) - log1pf(__expf(-fabsf(x))); }
DI float dir_scan(float v, int d, int lane) {
#pragma unroll
    for (int o = 1; o < 64; o <<= 1) { const float t = d == 0 ? __shfl_up(v, o) : __shfl_down(v, o); if (d == 0 ? lane >= o : lane + o < 64) v += t; }
    return v;
}
DI bf16x8 pack8(const float (&p)[8]) { u32x4 w; w.x = pg8::cvt_pk_nv(p[0], p[1]); w.y = pg8::cvt_pk_nv(p[2], p[3]); w.z = pg8::cvt_pk_nv(p[4], p[5]); w.w = pg8::cvt_pk_nv(p[6], p[7]); return __builtin_bit_cast(bf16x8, w); }

template <int RS> DI void stage_t32(const bf16_t* g, LAS unsigned char* img, int lane) {
    const bf16_t* src = g + (size_t)(lane >> 1) * ZC + (lane & 1) * 8;
    u32x4 w[4];
#pragma unroll
    for (int i = 0; i < 4; ++i) w[i] = *(const u32x4*)(src + 16 * i);
    LAS unsigned char* dst = img + (lane >> 1) * 2 + ((lane & 1) * 8) * RS;
#pragma unroll
    for (int i = 0; i < 4; ++i) { const unsigned ww[4] = {w[i].x, w[i].y, w[i].z, w[i].w};
#pragma unroll
        for (int jj = 0; jj < 4; ++jj) { *(LAS unsigned short*)(dst + (16 * i + 2 * jj) * RS) = (unsigned short)(ww[jj] & 0xffffu); *(LAS unsigned short*)(dst + (16 * i + 2 * jj + 1) * RS) = (unsigned short)(ww[jj] >> 16); } }
}
DI bf16x8 lds_frag64(const LAS unsigned char* p) { const u32x2 lo = *(const LAS u32x2*)p, hi = *(const LAS u32x2*)(p + 8); return __builtin_bit_cast(bf16x8, (u32x4){lo.x, lo.y, hi.x, hi.y}); }
constexpr int P1_RS = 72;
DI void mlstm_pass1(const Frame& F, int task) {
    const int c = task % 36, sq = task / 36, d = sq & 1, h = (sq >> 1) & 3, b = sq >> 3;
    const int row0 = chunk_row0(b, dir_chunk(d, c)), fr = F.lane & 15, quad = F.lane >> 4;
    LAS unsigned char* L = F.lds + F.wave * 16384; LAS unsigned char* KT = L; LAS unsigned char* VT = L + 64 * P1_RS; LAS float* wb = (LAS float*)(L + 2 * 64 * P1_RS);
    const bf16_t* Z = (const bf16_t*)(F.ws + WS_Z); const float* zg = (const float*)(F.ws + WS_ZG) + (size_t)(row0 + F.lane) * 16;
    const float xa = zg[d * 4 + h], lf = logsigmoidf_(zg[8 + d * 4 + h]);
    const float bs = dir_scan(lf, d, F.lane), bend = __shfl(bs, d == 0 ? 63 : 0);
    wb[F.lane] = __expf(bend - bs + xa);
    f32x4 acc[4][4];
#pragma unroll
    for (int i = 0; i < 4; ++i)
#pragma unroll
        for (int j = 0; j < 4; ++j) acc[i][j] = (f32x4){0.f, 0.f, 0.f, 0.f};
    float nacc = 0.f;
    const bf16_t* zc = Z + (size_t)row0 * ZC + h * 64;
#pragma unroll 1
    for (int half = 0; half < 2; ++half) {
        stage_t32<P1_RS>(zc + (size_t)(32 * half) * ZC + Z_MLK, KT, F.lane);
        stage_t32<P1_RS>(zc + (size_t)(32 * half) * ZC + Z_MLV, VT, F.lane);
        { LAS unsigned char* kr = KT + F.lane * P1_RS;
#pragma unroll
          for (int q = 0; q < 8; ++q) { u32x2 w = *(const LAS u32x2*)(kr + 8 * q); const f32x4 w4 = *(const LAS f32x4*)(wb + 32 * half + 4 * q);
              const float k0 = bflo(w.x) * w4[0], k1 = bfhi(w.x) * w4[1], k2 = bflo(w.y) * w4[2], k3 = bfhi(w.y) * w4[3]; nacc += (k0 + k1) + (k2 + k3);
              w.x = pg8::cvt_pk_bf16(k0, k1); w.y = pg8::cvt_pk_bf16(k2, k3); *(LAS u32x2*)(kr + 8 * q) = w; } }
        bf16x8 af[4], bfr[4];
#pragma unroll
        for (int i = 0; i < 4; ++i) { af[i] = lds_frag64(KT + (16 * i + fr) * P1_RS + quad * 16); bfr[i] = lds_frag64(VT + (16 * i + fr) * P1_RS + quad * 16); }
#pragma unroll
        for (int i = 0; i < 4; ++i)
#pragma unroll
            for (int j = 0; j < 4; ++j) acc[i][j] = __builtin_amdgcn_mfma_f32_16x16x32_bf16(af[i], bfr[j], acc[i][j], 0, 0, 0);
    }
    bf16_t* So = (bf16_t*)(F.ws + WS_SLOC_ML) + (size_t)task * 4096;
#pragma unroll
    for (int i = 0; i < 4; ++i)
#pragma unroll
        for (int j = 0; j < 4; ++j) { u32x2 w; w.x = pg8::cvt_pk_nv(acc[i][j][0], acc[i][j][1]); w.y = pg8::cvt_pk_nv(acc[i][j][2], acc[i][j][3]); *(u32x2*)(So + (16 * j + fr) * 64 + 16 * i + 4 * quad) = w; }
    ((float*)(F.ws + WS_MLN))[(size_t)task * 64 + F.lane] = nacc;
    if (F.lane == 0) ((float*)(F.ws + WS_MLP))[task] = __expf(bend);
}
template <bool PERCH> DI void carry_item(const bf16_t* sloc, const float* dec, bf16_t* sbf, int idx) {
    const int sq = idx >> 10, e = (idx & 1023) * 4;
    f32x4 S = (f32x4){0.f, 0.f, 0.f, 0.f};
#pragma unroll 1
    for (int c0 = 0; c0 < 36; c0 += 12) {
        u32x2 v[12]; f32x4 pd[12];
#pragma unroll
        for (int c = 0; c < 12; ++c) { v[c] = *(const u32x2*)(sloc + ((size_t)sq * 36 + c0 + c) * 4096 + e);
            if (PERCH) pd[c] = *(const f32x4*)(dec + ((size_t)sq * 36 + c0 + c) * 64 + (e & 63)); else { const float p1 = dec[sq * 36 + c0 + c]; pd[c] = (f32x4){p1, p1, p1, p1}; } }
#pragma unroll
        for (int c = 0; c < 12; ++c) {
            u32x2 w; w.x = pg8::cvt_pk_bf16(S[0], S[1]); w.y = pg8::cvt_pk_bf16(S[2], S[3]); *(u32x2*)(sbf + ((size_t)sq * 36 + c0 + c) * 4096 + e) = w;
            S = pd[c] * S + (f32x4){bflo(v[c].x), bfhi(v[c].x), bflo(v[c].y), bfhi(v[c].y)};
        }
    }
}
DI void carry_n_item(float* nb, const float* dec, int idx) {
    const int sq = idx >> 6, e = idx & 63;
    float v[36], dv[36];
#pragma unroll
    for (int c = 0; c < 36; ++c) { v[c] = nb[((size_t)sq * 36 + c) * 64 + e]; dv[c] = dec[sq * 36 + c]; }
    float S = 0.f;
#pragma unroll
    for (int c = 0; c < 36; ++c) { nb[((size_t)sq * 36 + c) * 64 + e] = S; S = dv[c] * S + v[c]; }
}
constexpr int VT_RS = 136;
constexpr int ML3_LDS = 8192 + 64 * 136 + 3 * 512;
constexpr size_t WS_MLO = WS_T1;
template <int d> DI void mlstm_dir(const Frame& F, int li, int bh, int tc, int row0, int fr, int quad,
                                   const LAS unsigned char* KI, const LAS unsigned char* VT, const LAS float* bb, const LAS float* ab, const LAS float* n0, f32x4* oscr, int ti_lo, int ti_hi) {
    const size_t st = (size_t)(bh * 2 + d) * 36 + dir_chunk(d, tc);
    const bf16_t* C0 = (const bf16_t*)(F.ws + WS_SBF_ML) + st * 4096;
    const int h = bh & 3;
    const bf16_t* zkq = (const bf16_t*)(F.ws + WS_Z) + (size_t)(row0 + fr) * ZC + h * 64 + 8 * quad;
    bf16x8 cf[4][2], qc[2];
    f32x4 nwv[4];
    if (d == 1) {
#pragma unroll
        for (int dvt = 0; dvt < 4; ++dvt) nwv[dvt] = *(const f32x4*)(F.in[I_MLNW] + li * 256 + h * 64 + 16 * dvt + 4 * quad); }
#pragma unroll
    for (int dvt = 0; dvt < 4; ++dvt)
#pragma unroll
        for (int ks = 0; ks < 2; ++ks) cf[dvt][ks] = *(const bf16x8*)(C0 + (16 * dvt + fr) * 64 + 32 * ks + 8 * quad);
#pragma unroll
    for (int ks = 0; ks < 2; ++ks) qc[ks] = *(const bf16x8*)(zkq + (size_t)(16 * ti_lo) * ZC + Z_MLQ + 32 * ks);
#pragma unroll 1
    for (int ti = ti_lo; ti < ti_hi; ++ti) {
        bf16x8 kf[4][2], qn[2];
#pragma unroll
        for (int si = 0; si < 4; ++si)
#pragma unroll
            for (int ks = 0; ks < 2; ++ks) kf[si][ks] = *(const LAS bf16x8*)(KI + (16 * si + fr) * 128 + (((4 * ks + quad) ^ ((fr >> 1) & 7)) * 16));
        { const int tn = ti < 3 ? ti + 1 : 3;
#pragma unroll
          for (int ks = 0; ks < 2; ++ks) qn[ks] = *(const bf16x8*)(zkq + (size_t)(16 * tn) * ZC + Z_MLQ + 32 * ks); }
        f32x4 pk[4]; u32x2 ozv[4];
        if (d == 1) { const bf16_t* zo = (const bf16_t*)(F.ws + WS_Z) + (size_t)(row0 + 16 * ti + fr) * ZC + Z_MLO + h * 64 + 4 * quad;
#pragma unroll
            for (int dvt = 0; dvt < 4; ++dvt) { pk[dvt] = oscr[(ti * 4 + dvt) * 64 + F.lane]; ozv[dvt] = *(const u32x2*)(zo + 16 * dvt); }
            __builtin_amdgcn_sched_barrier(0); }
        const float bt = bb[64 * d + 16 * ti + fr], ebt = __expf(bt);
        f32x4 num1[4], num2[4]; float den1 = 0.f, den2 = 0.f;
#pragma unroll
        for (int dvt = 0; dvt < 4; ++dvt) { num1[dvt] = (f32x4){0.f, 0.f, 0.f, 0.f}; num2[dvt] = (f32x4){0.f, 0.f, 0.f, 0.f}; }
#pragma unroll
        for (int ks = 0; ks < 2; ++ks) {
#pragma unroll
            for (int dvt = 0; dvt < 4; ++dvt) num2[dvt] = __builtin_amdgcn_mfma_f32_16x16x32_bf16(cf[dvt][ks], qc[ks], num2[dvt], 0, 0, 0);
            const f32x4 na = *(const LAS f32x4*)(n0 + 64 * d + 32 * ks + 8 * quad), nb2 = *(const LAS f32x4*)(n0 + 64 * d + 32 * ks + 8 * quad + 4);
            const u32x4 qw = __builtin_bit_cast(u32x4, qc[ks]);
            den2 += (bflo(qw.x) * na[0] + bfhi(qw.x) * na[1]) + (bflo(qw.y) * na[2] + bfhi(qw.y) * na[3]) + (bflo(qw.z) * nb2[0] + bfhi(qw.z) * nb2[1]) + (bflo(qw.w) * nb2[2] + bfhi(qw.w) * nb2[3]);
        }
        den2 += __shfl_xor(den2, 16); den2 += __shfl_xor(den2, 32);
#pragma unroll
        for (int g = 0; g < 2; ++g) {
            if (d == 0 ? (2 * g <= ti) : (2 * g + 1 >= ti)) {
                float p[8];
#pragma unroll
                for (int kk = 0; kk < 2; ++kk) {
                    const int si = 2 * g + kk;
                    f32x4 s4 = (f32x4){0.f, 0.f, 0.f, 0.f};
                    s4 = __builtin_amdgcn_mfma_f32_16x16x32_bf16(kf[si][0], qc[0], s4, 0, 0, 0);
                    s4 = __builtin_amdgcn_mfma_f32_16x16x32_bf16(kf[si][1], qc[1], s4, 0, 0, 0);
                    const f32x4 a4 = *(const LAS f32x4*)(ab + 64 * d + 16 * si + 4 * quad);
#pragma unroll
                    for (int j = 0; j < 4; ++j) { const int s = 16 * si + 4 * quad + j, t = 16 * ti + fr; const bool on = d == 0 ? (s <= t) : (s >= t);
                        const float wgt = on ? __expf(bt + a4[j]) : 0.f; p[4 * kk + j] = s4[j] * wgt; }
                }
                den1 += ((p[0] + p[1]) + (p[2] + p[3])) + ((p[4] + p[5]) + (p[6] + p[7]));
                const bf16x8 pf = pack8(p);
#pragma unroll
                for (int dvt = 0; dvt < 4; ++dvt) { const LAS unsigned char* vr = VT + (16 * dvt + fr) * VT_RS + (32 * g + 4 * quad) * 2;
                    const u32x2 lo = *(const LAS u32x2*)vr, hi = *(const LAS u32x2*)(vr + 32);
                    num1[dvt] = __builtin_amdgcn_mfma_f32_16x16x32_bf16(__builtin_bit_cast(bf16x8, (u32x4){lo.x, lo.y, hi.x, hi.y}), pf, num1[dvt], 0, 0, 0); }
            }
        }
        den1 += __shfl_xor(den1, 16); den1 += __shfl_xor(den1, 32);
        const float den = den1 + ebt * den2, inv = __builtin_amdgcn_rcpf(fmaxf(fabsf(den), 1.0f));
        f32x4 hs[4];
#pragma unroll
        for (int dvt = 0; dvt < 4; ++dvt) hs[dvt] = (num1[dvt] + num2[dvt] * ebt) * inv;
        if (d == 0) {
#pragma unroll
            for (int dvt = 0; dvt < 4; ++dvt) oscr[(ti * 4 + dvt) * 64 + F.lane] = hs[dvt];
        } else {
            float ss = 0.f;
#pragma unroll
            for (int dvt = 0; dvt < 4; ++dvt) { hs[dvt] = hs[dvt] + pk[dvt]; ss += (hs[dvt][0] * hs[dvt][0] + hs[dvt][1] * hs[dvt][1]) + (hs[dvt][2] * hs[dvt][2] + hs[dvt][3] * hs[dvt][3]); }
            ss += __shfl_xor(ss, 16); ss += __shfl_xor(ss, 32);
            const float rs = rsqrtf(ss * (1.0f / 64.0f) + EPS); const int row = row0 + 16 * ti + fr;
            bf16_t* mix = (bf16_t*)(F.ws + WS_MIX);
#pragma unroll
            for (int dvt = 0; dvt < 4; ++dvt) { const int ch = h * 64 + 16 * dvt + 4 * quad; const f32x4 w4 = nwv[dvt]; const u32x2 oz = ozv[dvt];
                u32x2 w; w.x = pg8::cvt_pk_bf16(hs[dvt][0] * rs * w4[0] * sigmoidf_(bflo(oz.x)), hs[dvt][1] * rs * w4[1] * sigmoidf_(bfhi(oz.x)));
                w.y = pg8::cvt_pk_bf16(hs[dvt][2] * rs * w4[2] * sigmoidf_(bflo(oz.y)), hs[dvt][3] * rs * w4[3] * sigmoidf_(bfhi(oz.y)));
                *(u32x2*)(mix + (size_t)row * D + 768 + ch) = w; }
        }
        qc[0] = qn[0]; qc[1] = qn[1];
    }
}
DI void mlstm_pass3(const Frame& F, int li, int task, int ti_lo = 0, int ti_hi = 4) {
    const int tc = task % 36, bh = task / 36, h = bh & 3, b = bh >> 2;
    const int row0 = chunk_row0(b, tc), fr = F.lane & 15, quad = F.lane >> 4;
    LAS unsigned char* L = F.lds + F.wave * ML3_LDS; LAS unsigned char* KI = L; LAS unsigned char* VT = L + 8192; LAS float* bb = (LAS float*)(VT + 64 * VT_RS); LAS float* ab = bb + 128; LAS float* n0 = ab + 128;
    { const bf16_t* zk = (const bf16_t*)(F.ws + WS_Z) + (size_t)(row0 + (F.lane >> 3)) * ZC + Z_MLK + h * 64 + (F.lane & 7) * 8;
      u32x4 kw[8];
#pragma unroll
      for (int i = 0; i < 8; ++i) kw[i] = *(const u32x4*)(zk + (size_t)(8 * i) * ZC);
#pragma unroll
      for (int i = 0; i < 8; ++i) { const int r = 8 * i + (F.lane >> 3); *(LAS u32x4*)(KI + r * 128 + (((F.lane & 7) ^ ((r >> 1) & 7)) * 16)) = kw[i]; } }
    const bf16_t* Z = (const bf16_t*)(F.ws + WS_Z);
    stage_t32<VT_RS>(Z + (size_t)row0 * ZC + Z_MLV + h * 64, VT, F.lane);
    stage_t32<VT_RS>(Z + (size_t)(row0 + 32) * ZC + Z_MLV + h * 64, VT + 64, F.lane);
#pragma unroll
    for (int d = 0; d < 2; ++d) {
        const size_t st = (size_t)(bh * 2 + d) * 36 + dir_chunk(d, tc);
        const float* zg = (const float*)(F.ws + WS_ZG) + (size_t)(row0 + F.lane) * 16; const float xa = zg[d * 4 + h], lf = logsigmoidf_(zg[8 + d * 4 + h]);
        const float bs = dir_scan(lf, d, F.lane); bb[64 * d + F.lane] = bs; ab[64 * d + F.lane] = xa - bs; n0[64 * d + F.lane] = ((const float*)(F.ws + WS_MLN))[st * 64 + F.lane];
    }
    f32x4* oscr = (f32x4*)(F.ws + WS_MLO) + (size_t)task * 16 * 64;
    mlstm_dir<0>(F, li, bh, tc, row0, fr, quad, KI, VT, bb, ab, n0, oscr, ti_lo, ti_hi);
    asm volatile("s_waitcnt vmcnt(0)" ::: "memory");
    mlstm_dir<1>(F, li, bh, tc, row0, fr, quad, KI, VT, bb, ab, n0, oscr, ti_lo, ti_hi);
}
DI float hg_forget(float lbv, unsigned short raw) { return lbv + (1.0f - lbv) * sigmoidf_(bf2f(raw)); }
template <int d> DI void hgrn2_pass1_dir(const Frame& F, int li, int task, int b, int h, int c) {
    const int row0 = chunk_row0(b, dir_chunk(d, c)), fr = F.lane & 15, quad = F.lane >> 4;
    LAS unsigned char* L = F.lds + F.wave * 16384; LAS unsigned char* KT = L; LAS unsigned char* VT = L + 64 * P1_RS;
    const bf16_t* zc = (const bf16_t*)(F.ws + WS_Z) + (size_t)row0 * ZC + h * 64;
    const float lbv = ((const float*)(F.ws + WS_LB))[(li * 2 + d) * 256 + h * 64 + F.lane];
    f32x4 acc[4][4];
#pragma unroll
    for (int i = 0; i < 4; ++i)
#pragma unroll
        for (int j = 0; j < 4; ++j) acc[i][j] = (f32x4){0.f, 0.f, 0.f, 0.f};
    float run = 1.0f;
#pragma unroll 1
    for (int hh = 0; hh < 2; ++hh) {
        const int half = d == 0 ? 1 - hh : hh;
        stage_t32<P1_RS>(zc + (size_t)(32 * half) * ZC + Z_HGF + d * 256, KT, F.lane);
        stage_t32<P1_RS>(zc + (size_t)(32 * half) * ZC + Z_HGI, VT, F.lane);
        { LAS unsigned char* kr = KT + F.lane * P1_RS;
          unsigned raw[16]; float kh[32];
#pragma unroll
          for (int q = 0; q < 8; ++q) { const u32x2 w = *(const LAS u32x2*)(kr + 8 * q); raw[2 * q] = w.x; raw[2 * q + 1] = w.y; }
#pragma unroll
          for (int it = 0; it < 32; ++it) { const int jj = d == 0 ? 31 - it : it; const unsigned short r = (unsigned short)((jj & 1) ? (raw[jj >> 1] >> 16) : (raw[jj >> 1] & 0xffffu));
              const float f = hg_forget(lbv, r); kh[jj] = (1.0f - f) * run; run *= f; }
#pragma unroll
          for (int q = 0; q < 8; ++q) { u32x2 w; w.x = pg8::cvt_pk_bf16(kh[4 * q], kh[4 * q + 1]); w.y = pg8::cvt_pk_bf16(kh[4 * q + 2], kh[4 * q + 3]); *(LAS u32x2*)(kr + 8 * q) = w; } }
        bf16x8 af[4], bfr[4];
#pragma unroll
        for (int i = 0; i < 4; ++i) { af[i] = lds_frag64(KT + (16 * i + fr) * P1_RS + quad * 16); bfr[i] = lds_frag64(VT + (16 * i + fr) * P1_RS + quad * 16); }
#pragma unroll
        for (int i = 0; i < 4; ++i)
#pragma unroll
            for (int j = 0; j < 4; ++j) acc[i][j] = __builtin_amdgcn_mfma_f32_16x16x32_bf16(af[i], bfr[j], acc[i][j], 0, 0, 0);
    }
    bf16_t* So = (bf16_t*)(F.ws + WS_SLOC_HG) + (size_t)task * 4096;
#pragma unroll
    for (int i = 0; i < 4; ++i)
#pragma unroll
        for (int j = 0; j < 4; ++j) { u32x2 w; w.x = pg8::cvt_pk_nv(acc[i][j][0], acc[i][j][1]); w.y = pg8::cvt_pk_nv(acc[i][j][2], acc[i][j][3]); *(u32x2*)(So + (16 * j + fr) * 64 + 16 * i + 4 * quad) = w; }
    ((float*)(F.ws + WS_HGP))[(size_t)task * 64 + F.lane] = run;
}
DI void hgrn2_pass1(const Frame& F, int li, int task) {
    const int c = task % 36, sq = task / 36, d = sq & 1, h = (sq >> 1) & 3, b = sq >> 3;
    if (d == 0) hgrn2_pass1_dir<0>(F, li, task, b, h, c); else hgrn2_pass1_dir<1>(F, li, task, b, h, c);
}
constexpr int HQ_RS = 144, HK_RS = 40;
DI void load_t16(const bf16_t* g, int lane, u32x4 (&w)[2]) { const bf16_t* src = g + (size_t)(lane >> 2) * ZC + (lane & 3) * 8; w[0] = *(const u32x4*)src; w[1] = *(const u32x4*)(src + 32); }
DI void store_t16(const u32x4 (&w)[2], LAS unsigned char* img, int lane) {
    LAS unsigned char* dst = img + (lane >> 2) * 2 + ((lane & 3) * 8) * HK_RS;
#pragma unroll
    for (int i = 0; i < 2; ++i) { const unsigned ww[4] = {w[i].x, w[i].y, w[i].z, w[i].w};
#pragma unroll
        for (int jj = 0; jj < 4; ++jj) { *(LAS unsigned short*)(dst + (32 * i + 2 * jj) * HK_RS) = (unsigned short)(ww[jj] & 0xffffu); *(LAS unsigned short*)(dst + (32 * i + 2 * jj + 1) * HK_RS) = (unsigned short)(ww[jj] >> 16); } }
}
template <int d> DI void hgrn2_pass3_dir(const Frame& F, int li, int bh, int tc, int row0, LAS unsigned char* L, f32x4* oscr) {
    const int h = bh & 3, fr = F.lane & 15, quad = F.lane >> 4;
    LAS unsigned char* Qt = L; LAS unsigned char* Kt = L + 16 * HQ_RS; LAS unsigned char* KhT = Kt + 16 * HQ_RS; LAS unsigned char* VTt = KhT + 64 * HK_RS; LAS unsigned char* QrT = VTt + 64 * HK_RS; LAS float* eBb = (LAS float*)(QrT + 64 * HK_RS);
    const bf16_t* zc = (const bf16_t*)(F.ws + WS_Z) + (size_t)row0 * ZC + h * 64;
    const float lbv = ((const float*)(F.ws + WS_LB))[(li * 2 + d) * 256 + h * 64 + F.lane];
    const size_t st = (size_t)(bh * 2 + d) * 36 + dir_chunk(d, tc);
    const bf16_t* S0 = (const bf16_t*)(F.ws + WS_SBF_HG) + st * 4096;
    f32x4 S[4][4];
#pragma unroll
    for (int i = 0; i < 4; ++i)
#pragma unroll
        for (int jt = 0; jt < 4; ++jt) { const u32x2 w = *(const u32x2*)(S0 + (16 * jt + fr) * 64 + 16 * i + 4 * quad); S[i][jt] = (f32x4){bflo(w.x), bfhi(w.x), bflo(w.y), bfhi(w.y)}; }
    u32x4 nf[2], nq[2], nv[2];
    f32x4 nwv[4];
    if (d == 1) {
#pragma unroll
        for (int dvt = 0; dvt < 4; ++dvt) nwv[dvt] = *(const f32x4*)(F.in[I_HGNW] + li * 256 + h * 64 + 16 * dvt + 4 * quad); }
    { const bf16_t* zn = zc + (size_t)(16 * (d == 0 ? 0 : 3)) * ZC; load_t16(zn + Z_HGF + d * 256, F.lane, nf); load_t16(zn + Z_HGQ, F.lane, nq); load_t16(zn + Z_HGI, F.lane, nv); }
#pragma unroll 1
    for (int uu = 0; uu < 4; ++uu) {
        const int u = d == 0 ? uu : 3 - uu, t0 = 16 * u;
        store_t16(nf, KhT, F.lane); store_t16(nq, QrT, F.lane); store_t16(nv, VTt, F.lane);
        if (uu < 3) { const bf16_t* zn = zc + (size_t)(16 * (d == 0 ? uu + 1 : 2 - uu)) * ZC; load_t16(zn + Z_HGF + d * 256, F.lane, nf); load_t16(zn + Z_HGQ, F.lane, nq); load_t16(zn + Z_HGI, F.lane, nv); }
        f32x4 pk[4]; u32x2 gzv[4];
        if (d == 1) { const bf16_t* zg_ = (const bf16_t*)(F.ws + WS_Z) + (size_t)(row0 + 16 * u + fr) * ZC + Z_HGG + h * 64 + 4 * quad;
#pragma unroll
            for (int dvt = 0; dvt < 4; ++dvt) { pk[dvt] = oscr[(u * 4 + dvt) * 64 + F.lane]; gzv[dvt] = *(const u32x2*)(zg_ + 16 * dvt); }
            __builtin_amdgcn_sched_barrier(0); }
        { float kt[16]; float run = 1.0f; unsigned rf[8], rq[8];
          { LAS unsigned char* fr_ = KhT + F.lane * HK_RS; LAS unsigned char* qr_ = QrT + F.lane * HK_RS;
#pragma unroll
            for (int q = 0; q < 4; ++q) { const u32x2 a = *(const LAS u32x2*)(fr_ + 8 * q), c2 = *(const LAS u32x2*)(qr_ + 8 * q); rf[2 * q] = a.x; rf[2 * q + 1] = a.y; rq[2 * q] = c2.x; rq[2 * q + 1] = c2.y; } }
#pragma unroll
          for (int it = 0; it < 16; ++it) {
              const int t = d == 0 ? it : 15 - it;
              const unsigned short rawf = (unsigned short)((t & 1) ? (rf[t >> 1] >> 16) : (rf[t >> 1] & 0xffffu)), rawq = (unsigned short)((t & 1) ? (rq[t >> 1] >> 16) : (rq[t >> 1] & 0xffffu));
              const float f = hg_forget(lbv, rawf);
              run = fmaxf(run * f, 1e-30f);
              *(LAS unsigned short*)(Qt + t * HQ_RS + F.lane * 2) = (unsigned short)(pg8::cvt_pk_nv(bf2f(rawq) * run, 0.f) & 0xffffu);
              kt[t] = (1.0f - f) * __builtin_amdgcn_rcpf(run);
              *(LAS unsigned short*)(Kt + t * HQ_RS + F.lane * 2) = (unsigned short)(pg8::cvt_pk_nv(kt[t], 0.f) & 0xffffu);
          }
          eBb[F.lane] = run;
#pragma unroll
          for (int q = 0; q < 4; ++q) { u32x2 w; w.x = pg8::cvt_pk_bf16(kt[4 * q] * run, kt[4 * q + 1] * run); w.y = pg8::cvt_pk_bf16(kt[4 * q + 2] * run, kt[4 * q + 3] * run); *(LAS u32x2*)(KhT + F.lane * HK_RS + 8 * q) = w; } }
        f32x4 at4 = (f32x4){0.f, 0.f, 0.f, 0.f};
#pragma unroll
        for (int ks = 0; ks < 2; ++ks) at4 = __builtin_amdgcn_mfma_f32_16x16x32_bf16(*(const LAS bf16x8*)(Kt + fr * HQ_RS + (32 * ks + 8 * quad) * 2), *(const LAS bf16x8*)(Qt + fr * HQ_RS + (32 * ks + 8 * quad) * 2), at4, 0, 0, 0);
        float p[8];
#pragma unroll
        for (int j = 0; j < 4; ++j) { const int s = 4 * quad + j; p[j] = (d == 0 ? (s <= fr) : (s >= fr)) ? at4[j] : 0.f; p[4 + j] = 0.f; }
        const bf16x8 pf = pack8(p);
        bf16x8 qp[2];
#pragma unroll
        for (int g = 0; g < 2; ++g) { const u32x2 lo = *(const LAS u32x2*)(Qt + fr * HQ_RS + (32 * g + 4 * quad) * 2), hi = *(const LAS u32x2*)(Qt + fr * HQ_RS + (32 * g + 16 + 4 * quad) * 2); qp[g] = __builtin_bit_cast(bf16x8, (u32x4){lo.x, lo.y, hi.x, hi.y}); }
        f32x4 o4s[4];
#pragma unroll
        for (int dvt = 0; dvt < 4; ++dvt) {
            const u32x2 vlo = *(const LAS u32x2*)(VTt + (16 * dvt + fr) * HK_RS + (4 * quad) * 2);
            f32x4 o4 = __builtin_amdgcn_mfma_f32_16x16x32_bf16(__builtin_bit_cast(bf16x8, (u32x4){vlo.x, vlo.y, 0u, 0u}), pf, (f32x4){0.f, 0.f, 0.f, 0.f}, 0, 0, 0);
#pragma unroll
            for (int g = 0; g < 2; ++g) { const float sp[8] = {S[2 * g][dvt][0], S[2 * g][dvt][1], S[2 * g][dvt][2], S[2 * g][dvt][3], S[2 * g + 1][dvt][0], S[2 * g + 1][dvt][1], S[2 * g + 1][dvt][2], S[2 * g + 1][dvt][3]};
                o4 = __builtin_amdgcn_mfma_f32_16x16x32_bf16(pack8(sp), qp[g], o4, 0, 0, 0); }
            o4s[dvt] = o4;
        }
        if (d == 0) {
#pragma unroll
            for (int dvt = 0; dvt < 4; ++dvt) oscr[(u * 4 + dvt) * 64 + F.lane] = o4s[dvt];
        } else {
            float ss = 0.f;
#pragma unroll
            for (int dvt = 0; dvt < 4; ++dvt) { o4s[dvt] = o4s[dvt] + pk[dvt]; ss += (o4s[dvt][0] * o4s[dvt][0] + o4s[dvt][1] * o4s[dvt][1]) + (o4s[dvt][2] * o4s[dvt][2] + o4s[dvt][3] * o4s[dvt][3]); }
            ss += __shfl_xor(ss, 16); ss += __shfl_xor(ss, 32);
            const float rs = rsqrtf(ss * (1.0f / 64.0f) + EPS); const int row = row0 + 16 * u + fr;
            bf16_t* mix = (bf16_t*)(F.ws + WS_MIX);
#pragma unroll
            for (int dvt = 0; dvt < 4; ++dvt) { const int ch = h * 64 + 16 * dvt + 4 * quad; const f32x4 w4 = nwv[dvt]; const u32x2 gz = gzv[dvt];
                u32x2 w; w.x = pg8::cvt_pk_bf16(o4s[dvt][0] * rs * w4[0] * siluf_(bflo(gz.x)), o4s[dvt][1] * rs * w4[1] * siluf_(bfhi(gz.x)));
                w.y = pg8::cvt_pk_bf16(o4s[dvt][2] * rs * w4[2] * siluf_(bflo(gz.y)), o4s[dvt][3] * rs * w4[3] * siluf_(bfhi(gz.y)));
                *(u32x2*)(mix + (size_t)row * D + ch) = w; }
        }
        bf16x8 af[4], bfr[4];
#pragma unroll
        for (int i = 0; i < 4; ++i) {
            const u32x4 a = __builtin_bit_cast(u32x4, lds_frag64(KhT + (16 * i + fr) * HK_RS + (quad & 1) * 16)), v = __builtin_bit_cast(u32x4, lds_frag64(VTt + (16 * i + fr) * HK_RS + (quad & 1) * 16));
            af[i] = __builtin_bit_cast(bf16x8, quad < 2 ? a : (u32x4){0u, 0u, 0u, 0u}); bfr[i] = __builtin_bit_cast(bf16x8, quad < 2 ? v : (u32x4){0u, 0u, 0u, 0u});
        }
#pragma unroll
        for (int i = 0; i < 4; ++i) { const f32x4 e4 = *(const LAS f32x4*)(eBb + 16 * i + 4 * quad);
#pragma unroll
            for (int jt = 0; jt < 4; ++jt) S[i][jt] = __builtin_amdgcn_mfma_f32_16x16x32_bf16(af[i], bfr[jt], S[i][jt] * e4, 0, 0, 0); }
    }
}
constexpr size_t WS_HGO = WS_T0;
DI void hgrn2_pass3(const Frame& F, int li, int task) {
    const int tc = task % 36, bh = task / 36, b = bh >> 2;
    const int row0 = chunk_row0(b, tc);
    LAS unsigned char* L = F.lds + F.wave * ML3_LDS;
    f32x4* oscr = (f32x4*)(F.ws + WS_HGO) + (size_t)task * 16 * 64;
    hgrn2_pass3_dir<0>(F, li, bh, tc, row0, L, oscr);
    asm volatile("s_waitcnt vmcnt(0)" ::: "memory");
    hgrn2_pass3_dir<1>(F, li, bh, tc, row0, L, oscr);
}
DI void select_task(const Frame& F, int task, int MT) {
    const int s = task >> 4, e = task & 15, n = s < 16 ? NL : NC, cap = n >> 3;
    LAS int* wsum = (LAS int*)F.lds;
    const float* aff = (const float*)(F.ws + WS_AFF) + ((size_t)s * 16 + e) * 2048;
    unsigned a[4];
    { const int i0 = 4 * F.tid; if (i0 < n) { const u32x4 w = *(const u32x4*)((const unsigned*)aff + i0); a[0] = w.x; a[1] = w.y; a[2] = w.z; a[3] = w.w; } else { a[0] = a[1] = a[2] = a[3] = 0u; } }
    __syncthreads();
    unsigned lo = 0u, hi = 0x7f800001u; int it = 0;
    while (hi - lo > 1u) {
        const unsigned mid = lo + ((hi - lo) >> 1);
        int c = 0;
#pragma unroll
        for (int j = 0; j < 4; ++j) c += __builtin_popcountll(__ballot(a[j] >= mid));
        LAS int* wb = wsum + (it & 1) * 8; if (F.lane == 0) wb[F.wave] = c;
        __syncthreads();
        int tot = 0;
#pragma unroll
        for (int w = 0; w < 8; ++w) tot += wb[w];
        if (tot >= cap) lo = mid; else hi = mid;
        ++it;
    }
    const unsigned thr = lo;
    LAS int* sc = wsum + 16;
    int ceq = 0, cgt = 0;
#pragma unroll
    for (int j = 0; j < 4; ++j) { ceq += a[j] == thr; cgt += a[j] > thr; }
    __syncthreads();
    { int c = cgt;
#pragma unroll
      for (int o = 1; o < 64; o <<= 1) c += __shfl_xor(c, o);
      if (F.lane == 0) sc[F.wave] = c; }
    __syncthreads();
    int totgt = 0;
#pragma unroll
    for (int w = 0; w < 8; ++w) totgt += sc[w];
    const int need_eq = cap - totgt;
    __syncthreads();
    int pre = ceq;
#pragma unroll
    for (int o = 1; o < 64; o <<= 1) { const int t = __shfl_up(pre, o); if (F.lane >= o) pre += t; }
    if (F.lane == 63) sc[F.wave] = pre;
    __syncthreads();
    int base = 0;
    for (int w = 0; w < F.wave; ++w) base += sc[w];
    int eqbefore = base + pre - ceq;
    bool sel[4]; int csel = 0;
#pragma unroll
    for (int j = 0; j < 4; ++j) { const bool iseq = a[j] == thr; sel[j] = (a[j] > thr) || (iseq && eqbefore < need_eq); eqbefore += iseq; csel += sel[j]; }
    __syncthreads();
    pre = csel;
#pragma unroll
    for (int o = 1; o < 64; o <<= 1) { const int t = __shfl_up(pre, o); if (F.lane >= o) pre += t; }
    if (F.lane == 63) sc[F.wave] = pre;
    __syncthreads();
    base = 0;
    for (int w = 0; w < F.wave; ++w) base += sc[w];
    int rank = base + pre - csel;
    int* inv = (int*)(F.ws + WS_INV) + ((size_t)s * 16 + e) * 2048; float* gate = (float*)(F.ws + WS_GATE); int* rsrc = (int*)(F.ws + WS_RSRC);
    if (4 * F.tid < n) {
#pragma unroll
        for (int j = 0; j < 4; ++j) { const int t = 4 * F.tid + j;
            if (sel[j]) { const int xr = xs_row(e, s, rank, MT); gate[xr] = __builtin_bit_cast(float, a[j]); rsrc[xr] = s < 16 ? s * NL + t : NLAT + (s - 16) * NC + t; inv[t] = rank; ++rank; } else inv[t] = -1; }
    }
    __syncthreads();
    __syncthreads();
}

#define XB_TMO      128
#define XB_XCNT(j)  (256  + 64 * (j))
#define XB_XSUB(j)  (1280 + 64 * (j))
#define XB_XGEN(j)  (2304 + 64 * (j))
#define XB_TOP      3328
#define XB_TOPGEN   3392
#define XCD_BAR_WORDS 3456
#define XB_SPIN_CAP (1u << 18)

__device__ __forceinline__ unsigned xb_ld(unsigned* p)              { return __hip_atomic_load(p, __ATOMIC_RELAXED, __HIP_MEMORY_SCOPE_AGENT); }
__device__ __forceinline__ unsigned xb_add(unsigned* p, unsigned v) { return __hip_atomic_fetch_add(p, v, __ATOMIC_RELAXED, __HIP_MEMORY_SCOPE_AGENT); }
__device__ __forceinline__ unsigned xb_xcc_id() { return (unsigned)__builtin_amdgcn_s_getreg((3 << 11) | 20) & 0xFu; }
#define XB_SPIN(cond, bar) do { unsigned _sp = 0; while (cond) { __builtin_amdgcn_s_sleep(1); \
    if ((++_sp & 255u) == 0u) { if (xb_ld(&(bar)[XB_TMO])) break; if (_sp > XB_SPIN_CAP) { atomicAdd(&(bar)[XB_TMO], 1u); break; } } } } while (0)

struct XcdBarrier {
    unsigned* bar; unsigned x;
    volatile LAS unsigned* st;
};

__device__ __forceinline__ XcdBarrier xcd_barrier_post(unsigned* bar, volatile LAS unsigned* st) {
    XcdBarrier b; b.bar = bar; b.x = xb_xcc_id(); b.st = st;
    if (threadIdx.x == 0) (void)xb_add(&bar[XB_XCNT(b.x)], 1u);
    return b;
}
__device__ __forceinline__ void xcd_barrier_complete(unsigned* bar, unsigned x, unsigned& nloc, unsigned& nx) {
    const unsigned G = gridDim.x * gridDim.y * gridDim.z;
    unsigned sum, cnt, mine, sp = 0u;
    for (;;) {
        sum = 0u; cnt = 0u; mine = 0u;
#pragma unroll
        for (unsigned j = 0; j < 16; ++j) { const unsigned c = xb_ld(&bar[XB_XCNT(j)]); sum += c; cnt += (c > 0u) ? 1u : 0u; mine = (j == x) ? c : mine; }
        if (sum == G) break;
        __builtin_amdgcn_s_sleep(1);
        if ((++sp & 255u) == 0u) { if (xb_ld(&bar[XB_TMO])) break; if (sp > XB_SPIN_CAP) { atomicAdd(&bar[XB_TMO], 1u); break; } }
    }
    nloc = mine > 0u ? mine : 1u; nx = cnt > 0u ? cnt : 1u;
}

__device__ __forceinline__ void xcd_barrier(const XcdBarrier& b) {
    asm volatile("s_waitcnt vmcnt(0)" ::: "memory");
    __syncthreads();
    if (threadIdx.x == 0) {
        unsigned* bar = b.bar;
        __builtin_amdgcn_s_waitcnt(0);
        unsigned nloc = b.st[0], nx = b.st[1];
        if (nloc == 0u) { xcd_barrier_complete(bar, b.x, nloc, nx); b.st[0] = nloc; b.st[1] = nx; }
        const unsigned old = xb_add(&bar[XB_XSUB(b.x)], 1u);
        const unsigned gen = old / nloc;
        if (old + 1u == (gen + 1u) * nloc) {
            __builtin_amdgcn_fence(__ATOMIC_RELEASE, "agent");
            asm volatile("s_waitcnt vmcnt(0)" ::: "memory");
            const unsigned og = xb_add(&bar[XB_TOP], 1u);
            const unsigned tg = og / nx;
            if (og + 1u == (tg + 1u) * nx) xb_add(&bar[XB_TOPGEN], 1u);
            else XB_SPIN(xb_ld(&bar[XB_TOPGEN]) == tg, bar);
            __builtin_amdgcn_fence(__ATOMIC_ACQUIRE, "agent");
            xb_add(&bar[XB_XGEN(b.x)], 1u);
            asm volatile("s_waitcnt vmcnt(0)" ::: "memory");
        } else {
            XB_SPIN(xb_ld(&bar[XB_XGEN(b.x)]) == gen, bar);
            __builtin_amdgcn_fence(__ATOMIC_ACQUIRE, "agent");
            asm volatile("s_waitcnt vmcnt(0)" ::: "memory");
        }
    }
    __syncthreads();
}
struct Args { const float* in[N_IN]; float* out; unsigned char* ws; int ph_lo, ph_hi; };
constexpr int PH_PER_LAYER = 11, PH_FINAL = 1 + DEPTH * PH_PER_LAYER, N_PHASES = PH_FINAL + 1;
#ifndef MK_N_LAUNCHES
#define MK_N_LAUNCHES 1
#endif
DI int fetch_task(unsigned* ctr, int lane) { int t = 0; if (lane == 0) t = (int)__hip_atomic_fetch_add(ctr, 1u, __ATOMIC_RELAXED, __HIP_MEMORY_SCOPE_AGENT); return __builtin_amdgcn_readfirstlane(t); }
#define TASK_LOOP(ctrword, N, call) do { unsigned* _c = (unsigned*)(F.ws + WS_CTL) + (ctrword); int _nx = fetch_task(_c, F.lane); while (_nx < (N)) { const int t = _nx; _nx = fetch_task(_c, F.lane); call; } } while (0)
constexpr int N_TAIL_IN = 8448, N_TAIL_OUT = 9216;
constexpr int N_PRECONV = 12288;
constexpr int CW_Q = 16384;
template <int li> DI void layer_body(const Frame& F, const XcdBarrier& bar, const int lo, const int hi) {
#define IN(k) (lo <= (k) && (k) < hi)
#define SEAM(k) do { if (IN((k) + 1)) xcd_barrier(bar); } while (0)

        const int pb = 1 + li * PH_PER_LAYER, MT = li == 0 ? 18 : 16;
        if (IN(pb + 0)) {
            phase_norm<0>(F, li);
            if (li > 0) { __syncthreads(); LAS float* scr = (LAS float*)(F.lds + 65536) + F.wave * (64 * 33);
                for (int it = F.bid * NWAVES + F.wave; it < NE * IT_EXP; it += F.G * NWAVES) { const int r = it % IT_EXP; if (F.G == 256 && r < 2048 && (it / IT_EXP) * 2048 + r < N_PRECONV) continue; expert_weight_item(F, li, it, scr); } }
            SEAM(pb + 0);
        }
        if (IN(pb + 1)) {
            __syncthreads();
            EpiInProj E{(bf16_t*)(F.ws + WS_Z), F.in[I_BIN] + li * INC, (const float*)(F.ws + WS_ROPE), (bf16_t*)(F.ws + WS_ACAT)};
            if (li < DEPTH - 1) { pg8::DenseOrder S; S.init(NTOK, ZC, F.G, F.bid, F.ws + WS_XN, D, F.ws + WS_WIN + (size_t)li * ZC * D * 2, D);
                pg8::gemm_phase<EpiInProj, pg8::DenseOrder, true, true>(F.lds, pg8::GemmDesc{D, D, D}, S, E);
}
            else { pg8::InProjLastOrder S; S.lat.init(NLAT, ZC, F.G, F.bid, F.ws + WS_XN, D, F.ws + WS_WIN + (size_t)li * ZC * D * 2, D); S.G = F.G; S.c = F.bid;
                pg8::gemm_phase<EpiInProj, pg8::InProjLastOrder, true, true>(F.lds, pg8::GemmDesc{D, D, D}, S, E); }
            SEAM(pb + 1);
        }
        if (IN(pb + 2)) {
            __syncthreads();
            { S5Order S{F.G, F.bid, (const char*)(F.ws + WS_ACAT), (const char*)(F.ws + WS_S5A) + (size_t)li * 16 * 256 * 256 * 2, (size_t)NCHK * 512 * 2, (size_t)256 * 256 * 2, (size_t)256 * 512 * 2};
              EpiS5A E{(bf16_t*)(F.ws + WS_XLOC)};
              pg8::gemm_phase<EpiS5A, S5Order, true, true>(F.lds, pg8::GemmDesc{256, 512, 256}, S, E);
            }
            __syncthreads();
            for (int t = F.bid * NWAVES + F.wave; t < 128 * 36; t += F.G * NWAVES) mlstm_pass1(F, t);
            for (int t = F.G * NWAVES - 1 - (F.bid * NWAVES + F.wave); t < 128 * 36; t += F.G * NWAVES) hgrn2_pass1(F, li, t);
            SEAM(pb + 2);
        }
        if (IN(pb + 3)) {
            __syncthreads();
            if (F.tid < 128) for (int i = F.bid * 128 + F.tid; i < 16 * 16 * 2 * 64; i += F.G * 128) s5_carry_item(F, li, i);
            for (int i = F.bid * NTHR + F.tid; i < 128 * 1024; i += F.G * NTHR) carry_item<false>((const bf16_t*)(F.ws + WS_SLOC_ML), (const float*)(F.ws + WS_MLP), (bf16_t*)(F.ws + WS_SBF_ML), i);
            for (int i = F.bid * NTHR + F.tid; i < 128 * 1024; i += F.G * NTHR) carry_item<true>((const bf16_t*)(F.ws + WS_SLOC_HG), (const float*)(F.ws + WS_HGP), (bf16_t*)(F.ws + WS_SBF_HG), i);
            { const int per = (128 * 64 + F.G - 1) / F.G, t0 = NTHR - per;
              if (per <= NTHR) { if (F.tid >= t0) { const int i = F.bid * per + (F.tid - t0); if (i < 128 * 64) carry_n_item((float*)(F.ws + WS_MLN), (const float*)(F.ws + WS_MLP), i); } }
              else for (int i = F.bid * NTHR + F.tid; i < 128 * 64; i += F.G * NTHR) carry_n_item((float*)(F.ws + WS_MLN), (const float*)(F.ws + WS_MLP), i); }
            { float lam_init; const float lam = da_lambda(F, li, lam_init); const int nat = li == 0 ? 512 + 64 : 512;
              for (int t = F.bid; t < nat; t += F.G) attn_unit(F, li, t, lam, lam_init);
            }
            SEAM(pb + 3);
        }
        if (IN(pb + 4)) {
            __syncthreads();
            { S5Order S{F.G, F.bid, (const char*)(F.ws + WS_ACAT), (const char*)(F.ws + WS_S5B) + (size_t)li * 16 * 256 * 512 * 2, (size_t)NCHK * 512 * 2, (size_t)256 * 512 * 2, (size_t)256 * 512 * 2};
              EpiS5B E{(const bf16_t*)(F.ws + WS_ACAT), F.in[I_S5D] + li * 256, (bf16_t*)(F.ws + WS_MIX)};
              pg8::gemm_phase<EpiS5B, S5Order, true, true>(F.lds, pg8::GemmDesc{512, 512, 512}, S, E);
            }
            __syncthreads();
            if (F.G == 256 && li == 0) {
                const int gw = F.bid * NWAVES + F.wave, x = gw - 144 * NWAVES;
                mlstm_pass3(F, li, gw); if (x >= 0 && x < 256) mlstm_pass3(F, li, 2048 + x);
                hgrn2_pass3(F, li, gw); if (x >= 256 && x < 512) hgrn2_pass3(F, li, 2048 + (x - 256));
            } else {
            for (int t = F.bid * NWAVES + F.wave; t < 64 * (li == 0 ? 36 : 32); t += F.G * NWAVES) mlstm_pass3(F, li, li == 0 ? t : (t >> 5) * 36 + 4 + (t & 31));
            for (int t = F.G * NWAVES - 1 - (F.bid * NWAVES + F.wave); t < 64 * (li == 0 ? 36 : 32); t += F.G * NWAVES) hgrn2_pass3(F, li, li == 0 ? t : (t >> 5) * 36 + 4 + (t & 31));
            }
            SEAM(pb + 4);
        }
        if (IN(pb + 5)) {
            __syncthreads();
            { pg8::DenseOrder S; S.init(li == 0 ? NTOK : NLAT, 256, F.G, F.bid, F.ws + WS_MIX + 512, D, F.ws + WS_GLUW + (size_t)li * 256 * 256 * 2, 256);
              EpiGLU E{(bf16_t*)(F.ws + WS_MIX), F.in[I_S5GB] + li * 256};
              pg8::gemm_phase<EpiGLU, pg8::DenseOrder, true, true>(F.lds, pg8::GemmDesc{256, D, 256}, S, E); }

            SEAM(pb + 5);
        }
        if (IN(pb + 6)) {
            __syncthreads();
            pg8::DenseOrder S; S.init(li == 0 ? NTOK : NLAT, D, F.G, F.bid, F.ws + WS_MIX, D, F.ws + WS_WOUT + (size_t)li * D * D * 2, D);
            EpiOutProj E{F.in[I_X], F.in[I_CTX], li == 0 ? nullptr : (const bf16_t*)(F.ws + WS_HL), (bf16_t*)(F.ws + WS_HL), (const float*)(F.ws + WS_MOD) + (size_t)li * 17 * 6144 + 2 * 1024};
            pg8::gemm_phase<EpiOutProj, pg8::DenseOrder, true, true>(F.lds, pg8::GemmDesc{D, D, D}, S, E);

            SEAM(pb + 6);
        }
        if (IN(pb + 7)) { __syncthreads(); phase_norm<1>(F, li); SEAM(pb + 7); }
        if (IN(pb + 8)) { __syncthreads(); const int nt = li == 0 ? 512 : 256; for (int t = F.bid; t < nt; t += F.G) select_task(F, t, MT); SEAM(pb + 8); }
        if (IN(pb + 9)) {
            __syncthreads();
            pg8::MoeOrder<true> S{(const int*)(F.ws + WS_RSRC), MT, 16, F.G, F.bid, (const char*)(F.ws + WS_XN), (const char*)(F.ws + WS_W13), (size_t)256 * D * 2, (size_t)MT * 256 * D * 2, (size_t)256 * D * 2, (size_t)4096 * D * 2};
            EpiSwiGLU E{(bf16_t*)(F.ws + WS_H), MT};
            pg8::gemm_phase<EpiSwiGLU, pg8::MoeOrder<true>, true, true>(F.lds, pg8::GemmDesc{D, D, D}, S, E);
            SEAM(pb + 9);
        }
        if (IN(pb + 10)) {
            __syncthreads();
            pg8::MoeOrder<false> S{nullptr, MT, 4, F.G, F.bid, (const char*)(F.ws + WS_H), (const char*)(F.ws + WS_W2), (size_t)256 * DE * 2, (size_t)MT * 256 * DE * 2, (size_t)256 * DE * 2, (size_t)D * DE * 2};
            EpiDown E{(bf16_t*)(F.ws + WS_XS), (const float*)(F.ws + WS_GATE), MT};
            pg8::gemm_phase<EpiDown, pg8::MoeOrder<false>, true, true>(F.lds, pg8::GemmDesc{DE, DE, DE}, S, E);
            if (li < DEPTH - 1 && F.G == 256 && (F.bid >> 3) >= 16) {
                __syncthreads(); LAS float* scr = (LAS float*)F.lds + F.wave * (64 * 33);
                for (int j = (((F.bid >> 3) - 16) * 8 + (F.bid & 7)) * NWAVES + F.wave; j < N_PRECONV; j += 128 * NWAVES) expert_weight_item(F, li + 1, (j >> 11) * IT_EXP + (j & 2047), scr);
            }
            SEAM(pb + 10);
        }

#undef IN
#undef SEAM
}
__global__ void __launch_bounds__(NTHR, 2) fwd_kernel(Args args) {
    extern __shared__ __attribute__((aligned(16))) unsigned char lds_raw[];
    Frame F; F.lds = (LAS unsigned char*)lds_raw; F.ws = args.ws; F.in = args.in; F.out = args.out;
    F.tid = threadIdx.x; F.lane = F.tid & 63; F.wave = __builtin_amdgcn_readfirstlane(F.tid >> 6); F.bid = blockIdx.x; F.G = gridDim.x;
    volatile LAS unsigned* MISC = (volatile LAS unsigned*)(F.lds + MISC_OFF);
    if (F.tid < 32) MISC[F.tid] = 0u;
    __syncthreads();
    XcdBarrier bar = xcd_barrier_post((unsigned*)(F.ws + WS_CTL) + CW_BAR, MISC + 8);
    const int lo = args.ph_lo, hi = args.ph_hi;
#define IN(k) (lo <= (k) && (k) < hi)
#define SEAM(k) do { if (IN((k) + 1)) xcd_barrier(bar); } while (0)
    if (IN(0)) { phase_prologue(F);
      SEAM(0); }
    layer_body<0>(F, bar, lo, hi);
    layer_body<1>(F, bar, lo, hi);
    if (IN(PH_FINAL)) { __syncthreads(); phase_norm<2>(F, DEPTH - 1);
    }
#undef IN
#undef SEAM
}

extern "C" void kernel_launch(void* const* d_in, const int* in_sizes, int n_in, void* d_out, int out_size, void* d_ws, size_t ws_size, hipStream_t stream) {
    static int grid = 0;
    if (grid == 0) {
        if (n_in != N_IN || out_size != NLAT * D || ws_size < WS_END) { fprintf(stderr, "kernel_launch: unexpected shapes (n_in %d, out %d, ws %zu < %zu)\n", n_in, out_size, ws_size, (size_t)WS_END); grid = -1; return; }
        int dev = 0, cus = 0, per_cu = 0;
        if (hipGetDevice(&dev) != hipSuccess || hipDeviceGetAttribute(&cus, hipDeviceAttributeMultiprocessorCount, dev) != hipSuccess) { grid = -1; return; }
        if (hipFuncSetAttribute((const void*)fwd_kernel, hipFuncAttributeMaxDynamicSharedMemorySize, LDS_BYTES) != hipSuccess) { fprintf(stderr, "kernel_launch: hipFuncSetAttribute failed\n"); grid = -1; return; }
        if (hipOccupancyMaxActiveBlocksPerMultiprocessor(&per_cu, (const void*)fwd_kernel, NTHR, LDS_BYTES) != hipSuccess || per_cu < 1) fprintf(stderr, "kernel_launch: occupancy query says %d\n", per_cu);
        (void)hipGetLastError();
        grid = cus;
    }
    if (grid < 0) return;
    (void)hipMemsetAsync((char*)d_ws + WS_CTL, 0, CTL_BYTES, stream);
    Args a{};
    for (int i = 0; i < N_IN; ++i) a.in[i] = (const float*)d_in[i];
    a.out = (float*)d_out; a.ws = (unsigned char*)d_ws;
    const int nl = MK_N_LAUNCHES;
    for (int l = 0; l < nl; ++l) {
        a.ph_lo = (int)((long)l * N_PHASES / nl); a.ph_hi = (int)((long)(l + 1) * N_PHASES / nl);
        hipLaunchKernelGGL(fwd_kernel, dim3(grid), dim3(NTHR), LDS_BYTES, stream, a);
    }
}
```

```cpp
#include <hip/hip_runtime.h>
#include <cstdio>
#include <cstdint>

#define LAS __attribute__((address_space(3)))
#define GAS __attribute__((address_space(1)))
typedef unsigned short bf16_t;
typedef short bf16x8 __attribute__((ext_vector_type(8)));
typedef float f32x4 __attribute__((ext_vector_type(4)));
typedef float f32x2 __attribute__((ext_vector_type(2)));
typedef unsigned u32x4 __attribute__((ext_vector_type(4)));
typedef unsigned u32x2 __attribute__((ext_vector_type(2)));
#define DI __device__ __forceinline__

constexpr int NB = 16, NL = 2048, NC = 256, D = 1024, DEPTH = 2;
constexpr int NLAT = NB * NL;
constexpr int NCTX = NB * NC;
constexpr int NTOK = NLAT + NCTX;
constexpr int ZC = 3328;
constexpr int INC = 3344;
constexpr int GW = 256;
constexpr int Z_HGQ = 0, Z_HGI = 256, Z_HGF = 512, Z_HGG = 1024, Z_S5 = 1280, Z_DAQ = 1536, Z_DAK = 1792, Z_DAV = 2048, Z_MLQ = 2304, Z_MLK = 2560, Z_MLV = 2816, Z_MLO = 3072;
constexpr int NE = 16, DE = 2048;
constexpr float EPS = 1e-6f;

constexpr size_t MiB = 1u << 20;
constexpr size_t WS_CTL = 0, CTL_BYTES = 1 * MiB;
constexpr size_t WS_MOD = 1 * MiB;
constexpr size_t WS_ROPE = 2 * MiB;
constexpr size_t WS_LB = 2 * MiB + 512 * 1024;
constexpr size_t WS_WTG = 2 * MiB + 512 * 1024 + 64 * 1024;
constexpr size_t WS_AFF = 3 * MiB;
constexpr size_t WS_GATE = 7 * MiB;
constexpr size_t WS_RSRC = 7 * MiB + 512 * 1024;
constexpr size_t WS_INV = 8 * MiB;
constexpr size_t WS_ZG = 12 * MiB;
constexpr size_t WS_WIN = 15 * MiB;
constexpr size_t WS_WOUT = 28 * MiB;
constexpr size_t WS_W13 = 40 * MiB;
constexpr size_t WS_W2 = 168 * MiB;
constexpr size_t WS_HL = 232 * MiB;
constexpr size_t WS_XN = 376 * MiB;
constexpr size_t WS_ARENA = 448 * MiB;
constexpr size_t WS_Z = WS_ARENA;
constexpr size_t WS_MIX = WS_ARENA + 234 * MiB;
constexpr size_t WS_T0 = WS_ARENA + 306 * MiB;
constexpr size_t WS_T1 = WS_ARENA + 378 * MiB;
constexpr size_t WS_T2 = WS_ARENA + 450 * MiB;
constexpr size_t WS_XS = WS_ARENA;
constexpr size_t WS_H = WS_ARENA + 144 * MiB;
constexpr size_t WS_END = WS_ARENA + 522 * MiB;
constexpr size_t WS_GLUW = WS_T2 + 68 * MiB;
constexpr int P0_SKIP = 8448 + 9216;
constexpr int CW_BAR = 4096;

constexpr int NWAVES = 8, NTHR = 512;
constexpr int LDS_BYTES = 147456 + 512;
constexpr int RING_BYTES = 131072;
constexpr int MISC_OFF = LDS_BYTES - 256;

DI unsigned f2bf(float f) { unsigned u = __builtin_bit_cast(unsigned, f); return (u + 0x7fffu + ((u >> 16) & 1u)) >> 16; }
DI unsigned pk2(float lo, float hi) { return f2bf(lo) | (f2bf(hi) << 16); }
DI float bf2f(unsigned short b) { return __builtin_bit_cast(float, (unsigned)b << 16); }
DI float bflo(unsigned w) { return __builtin_bit_cast(float, w << 16); }
DI float bfhi(unsigned w) { return __builtin_bit_cast(float, w & 0xffff0000u); }
DI float dpp_add(float v, const int ctrl_tag) {
    const int x = __builtin_bit_cast(int, v); int t;
    if (ctrl_tag == 0) t = __builtin_amdgcn_update_dpp(0, x, 0xB1, 0xF, 0xF, true);
    else if (ctrl_tag == 1) t = __builtin_amdgcn_update_dpp(0, x, 0x4E, 0xF, 0xF, true);
    else if (ctrl_tag == 2) t = __builtin_amdgcn_update_dpp(0, x, 0x141, 0xF, 0xF, true);
    else t = __builtin_amdgcn_update_dpp(0, x, 0x140, 0xF, 0xF, true);
    return v + __builtin_bit_cast(float, t);
}
DI float dpp_perm(float v, const int ctrl_tag) {
    const int x = __builtin_bit_cast(int, v);
    const int t = ctrl_tag == 2 ? __builtin_amdgcn_update_dpp(0, x, 0x141, 0xF, 0xF, true) : __builtin_amdgcn_update_dpp(0, x, 0x140, 0xF, 0xF, true);
    return __builtin_bit_cast(float, t);
}
DI float row_lane(float v, int l) { return __builtin_bit_cast(float, __builtin_amdgcn_readlane(__builtin_bit_cast(int, v), l)); }
DI float wave_sum(float v) {
    v = dpp_add(v, 0); v = dpp_add(v, 1); v = dpp_add(v, 2); v = dpp_add(v, 3);
    const int x = __builtin_bit_cast(int, v);
    const float r0 = __builtin_bit_cast(float, __builtin_amdgcn_readlane(x, 0)), r1 = __builtin_bit_cast(float, __builtin_amdgcn_readlane(x, 16)), r2 = __builtin_bit_cast(float, __builtin_amdgcn_readlane(x, 32)), r3 = __builtin_bit_cast(float, __builtin_amdgcn_readlane(x, 48));
    return (r0 + r1) + (r2 + r3);
}
DI float sigmoidf_(float x) { return __builtin_amdgcn_rcpf(1.0f + __expf(-x)); }
DI float siluf_(float x) { return x * __builtin_amdgcn_rcpf(1.0f + __expf(-x)); }
namespace pg8 {
#define PG8_LAS __attribute__((address_space(3)))
constexpr int BM = 256, BK = 64, HALF = 128, HTB = HALF * BK * 2, STAGE_BYTES = 8 * HTB, NXCD = 8, WGM = 8;
__host__ __device__ __forceinline__ int lds_byte(int r, int c) { const int st = (r >> 4) * 2 + (c >> 5), rr = r & 15, cc = c & 31, ob = rr * 64 + cc * 2; return st * 1024 + (ob ^ (((ob >> 9) & 1) << 5)); }
__host__ __device__ __forceinline__ void stage_rc(int b, int& R, int& C) { const int st = b / 1024, sb = b % 1024, swz = sb ^ (((sb >> 9) & 1) << 5); R = (st >> 1) * 16 + swz / 64; C = (st & 1) * 32 + (swz % 64) / 2; }
__host__ __device__ __forceinline__ int perm32(int rho) { const int n = rho >> 4, i = rho & 15; return 8 * (i >> 2) + 4 * n + (i & 3); }
struct Unit { int pm, pn, g; };
struct GemmDesc { int K, lda, ldb; };
struct DenseOrder {
    static constexpr bool GATHER = false; __device__ __forceinline__ const int* row_tab(const Unit&) const { return nullptr; }
    int nM, nN, nwg, G, c; const char* A; const char* B; size_t ta, tb;
    __device__ void init(int M, int N, int G_, int c_, const void* A_, size_t lda, const void* B_, size_t ldb) { nM = M / BM; nN = N / BM; nwg = nM * nN; G = G_; c = c_; A = (const char*)A_; B = (const char*)B_; ta = (size_t)BM * lda * 2; tb = (size_t)BM * ldb * 2; }
    __device__ bool next(int i, Unit& u) const {
        const long L = (long)i * G + c; if (L >= nwg) return false;
        int wgid = (int)L; { const int q = nwg / NXCD, r = nwg % NXCD, xcd = wgid % NXCD, off = wgid / NXCD; wgid = (xcd < r ? xcd * (q + 1) : r * (q + 1) + (xcd - r) * q) + off; }
        const int nig = WGM * nN, gid = wgid / nig, fm = gid * WGM, gsz = (nM - fm) < WGM ? (nM - fm) : WGM;
        u.pm = fm + ((wgid % nig) % gsz); u.pn = (wgid % nig) / gsz; u.g = 0; return true;
    }
    __device__ __forceinline__ const char* a_ptr(const Unit& u) const { return A + (size_t)u.pm * ta; }
    __device__ __forceinline__ const char* b_ptr(const Unit& u) const { return B + (size_t)u.pn * tb; }
    __device__ __forceinline__ void a_ready(const Unit&) const {}
    __device__ __forceinline__ void done(const Unit&) const {}
};
struct InProjLastOrder {
    static constexpr bool GATHER = false; __device__ __forceinline__ const int* row_tab(const Unit&) const { return nullptr; }
    DenseOrder lat; int G, c;
    __device__ bool next(int i, Unit& u) const {
        const long L = (long)i * G + c;
        if (L < lat.nwg) return lat.next(i, u);
        const int r = (int)(L - lat.nwg); if (r >= 16 * 8) return false;
        const int tab = r & 7; u.pm = 128 + (r >> 3); u.pn = tab == 0 ? 1 : tab == 1 ? 2 : tab == 2 ? 3 : tab == 3 ? 5 : tab == 4 ? 7 : tab == 5 ? 8 : tab == 6 ? 10 : 11; u.g = 0; return true;
    }
    __device__ __forceinline__ const char* a_ptr(const Unit& u) const { return lat.a_ptr(u); }
    __device__ __forceinline__ const char* b_ptr(const Unit& u) const { return lat.b_ptr(u); }
    __device__ __forceinline__ void a_ready(const Unit&) const {}
    __device__ __forceinline__ void done(const Unit&) const {}
};
template <bool GATH> struct MoeOrder {
    static constexpr bool GATHER = GATH; const int* tab;
    __device__ __forceinline__ const int* row_tab(const Unit& u) const { return tab + (size_t)(u.g * MT + u.pm) * 256; }
    int MT, NT, G, c; const char* A; const char* B; size_t ta, ga, tb, gb;
    __device__ bool next(int i, Unit& u) const {
        const int per = MT * NT;
        if (G == 256) {
            const int xg = c & 7, r = c >> 3, idx = i * 32 + r; if (idx >= 2 * per) return false;
            const int el = idx / per, v = idx % per; u.g = xg * 2 + el;
            if (NT == 16) { const int blk = v / (MT * 8), w = v % (MT * 8); u.pm = w / 8; u.pn = blk * 8 + (w % 8); }
            else { u.pm = v / NT; u.pn = v % NT; }
            return true;
        }
        const long L = (long)i * G + c; if (L >= (long)16 * per) return false;
        u.g = (int)(L / per); const int v = (int)(L % per); u.pm = v / NT; u.pn = v % NT; return true;
    }
    __device__ __forceinline__ const char* a_ptr(const Unit& u) const { return GATH ? A : A + (size_t)u.g * ga + (size_t)u.pm * ta; }
    __device__ __forceinline__ const char* b_ptr(const Unit& u) const { return B + (size_t)u.g * gb + (size_t)u.pn * tb; }
    __device__ __forceinline__ void a_ready(const Unit&) const {}
    __device__ __forceinline__ void done(const Unit&) const {}
};
__device__ __forceinline__ unsigned cvt_pk_bf16(float lo, float hi) { unsigned r; asm volatile("v_cvt_pk_bf16_f32 %0, %1, %2" : "=v"(r) : "v"(lo), "v"(hi)); return r; }
typedef __bf16 bf16v2 __attribute__((ext_vector_type(2)));
__device__ __forceinline__ unsigned cvt_pk_nv(float lo, float hi) { const bf16v2 v = {(__bf16)lo, (__bf16)hi}; return __builtin_bit_cast(unsigned, v); }
template <class Epi, class Sched, bool ALIGN_EPI = false, bool SP2 = false>
__device__ __forceinline__ void gemm_phase(PG8_LAS unsigned char* lds, const GemmDesc g, const Sched& S, const Epi& E) {
    const int tid = threadIdx.x, wid = __builtin_amdgcn_readfirstlane(tid >> 6), lane = tid & 63, wr = wid >> 2, wc = wid & 3, fr = lane & 15, fq = lane >> 4;
    int Kop = g.K; asm volatile("" : "+s"(Kop));
    const int K = Kop, nt = K / BK;
    unsigned vA0[2], vA1[2], nA0[2], nA1[2], voffB[2]; int Rr[2]; unsigned colb[2];
#pragma unroll
    for (int i = 0; i < 2; ++i) { int R, C; stage_rc(tid * 16 + i * 8192, R, C); const int Rb = Epi::PERM ? ((R & ~31) + perm32(R & 31)) : R; Rr[i] = R; colb[i] = (unsigned)C * 2u;
        vA0[i] = (unsigned)(R * g.lda + C) * 2u; vA1[i] = vA0[i] + (unsigned)(HALF * g.lda * 2); voffB[i] = (unsigned)(Rb * g.ldb + C) * 2u; }
#define PG8_GATHER(u, v0, v1) do { const int* _tab = S.row_tab(u); _Pragma("unroll") for (int _i = 0; _i < 2; ++_i) { (v0)[_i] = (unsigned)_tab[Rr[_i]] * (unsigned)(g.lda * 2) + colb[_i]; (v1)[_i] = (unsigned)_tab[HALF + Rr[_i]] * (unsigned)(g.lda * 2) + colb[_i]; } } while (0)
    const size_t kstep = (size_t)(BK * 2);
    const size_t hstepB = (size_t)HALF * g.ldb * 2;
    const unsigned ldsw = (unsigned)wid * 1024u;
    const int aoff = lds_byte(wr * 64 + fr, fq * 8), boff = lds_byte(wc * 32 + fr, fq * 8);
#define PG8_SA(b, h) (((b) * 2 + (h)) * HTB)
#define PG8_SB(b, h) ((4 + (b) * 2 + (h)) * HTB)
#define PG8_STAGE(bufoff, gbase, voff) do { _Pragma("unroll") for (int _i = 0; _i < 2; ++_i) \
        __builtin_amdgcn_global_load_lds((const unsigned*)((const char*)(gbase) + (voff)[_i]), (PG8_LAS unsigned*)(lds + (bufoff) + ldsw + _i * 8192), 16, 0, 0); } while (0)
#define PG8_LDA(dst, b, h) do { _Pragma("unroll") for (int m = 0; m < 4; ++m) _Pragma("unroll") for (int k = 0; k < 2; ++k) dst[m][k] = *(const PG8_LAS bf16x8*)(lds + PG8_SA(b, h) + aoff + m * 2048 + k * 1024); } while (0)
#define PG8_LDB(dst, b, h) do { _Pragma("unroll") for (int n = 0; n < 2; ++n) _Pragma("unroll") for (int k = 0; k < 2; ++k) dst[n][k] = *(const PG8_LAS bf16x8*)(lds + PG8_SB(b, h) + boff + n * 2048 + k * 1024); } while (0)
#define PG8_MMA(ai, bj, At, Bt) do { __builtin_amdgcn_s_setprio(1); _Pragma("unroll") for (int m = 0; m < 4; ++m) _Pragma("unroll") for (int n = 0; n < 2; ++n) _Pragma("unroll") for (int k = 0; k < 2; ++k) \
        acc[ai][bj][m][n] = __builtin_amdgcn_mfma_f32_16x16x32_bf16(Bt[n][k], At[m][k], acc[ai][bj][m][n], 0, 0, 0); __builtin_amdgcn_s_setprio(0); } while (0)
#define PG8_WAIT_V(n) asm volatile("s_waitcnt vmcnt(" #n ")" ::: "memory")
#define PG8_WAIT_L(n) asm volatile("s_waitcnt lgkmcnt(" #n ")" ::: "memory")
#define PG8_BAR __builtin_amdgcn_s_barrier()
#define PG8_SCHED __builtin_amdgcn_sched_barrier(0)
    Unit cur, nxt; int ui = 0;
    if (!S.next(0, cur)) return;
    f32x4 acc[2][2][4][2];
#pragma unroll
    for (int a = 0; a < 2; ++a)
#pragma unroll
        for (int b = 0; b < 2; ++b)
#pragma unroll
            for (int m = 0; m < 4; ++m)
#pragma unroll
                for (int n = 0; n < 2; ++n) acc[a][b][m][n] = (f32x4){0.f, 0.f, 0.f, 0.f};
    bf16x8 At[4][2], B0[2][2], B1[2][2];
    const char* cA = S.a_ptr(cur); const char* cB = S.b_ptr(cur);
    if constexpr (Sched::GATHER) PG8_GATHER(cur, vA0, vA1);
#pragma unroll
    for (int i = 0; i < 2; ++i) { nA0[i] = vA0[i]; nA1[i] = vA1[i]; }
    S.a_ready(cur);
    if constexpr (SP2) {
        PG8_STAGE(PG8_SB(0, 0), cB, voffB); PG8_STAGE(PG8_SB(0, 1), cB + hstepB, voffB); PG8_STAGE(PG8_SA(0, 0), cA, vA0); PG8_STAGE(PG8_SA(0, 1), cA, vA1);
        if (wr == 1) PG8_BAR;
        PG8_WAIT_V(2); PG8_BAR;
        PG8_STAGE(PG8_SB(1, 0), cB + kstep, voffB); PG8_STAGE(PG8_SA(1, 0), cA + kstep, vA0); PG8_STAGE(PG8_SB(1, 1), cB + hstepB + kstep, voffB);
        PG8_WAIT_V(6); PG8_BAR;
    } else {
        PG8_STAGE(PG8_SB(0, 0), cB, voffB); PG8_STAGE(PG8_SA(0, 0), cA, vA0); PG8_STAGE(PG8_SB(0, 1), cB + hstepB, voffB); PG8_STAGE(PG8_SA(0, 1), cA, vA1);
        if (wr == 1) PG8_BAR;
        PG8_WAIT_V(4); PG8_BAR;
        PG8_STAGE(PG8_SB(1, 0), cB + kstep, voffB); PG8_STAGE(PG8_SA(1, 0), cA + kstep, vA0); PG8_STAGE(PG8_SB(1, 1), cB + hstepB + kstep, voffB);
        PG8_WAIT_V(6); PG8_BAR;
    }
    for (;;) {
        const bool has_next = S.next(ui + 1, nxt);
        const char* nA = has_next ? S.a_ptr(nxt) : cA; const char* nB = has_next ? S.b_ptr(nxt) : cB;
        if constexpr (Sched::GATHER) { if (has_next) PG8_GATHER(nxt, nA0, nA1); }
#pragma unroll 1
        for (int t = 0; t < nt; t += 2) {
            const bool last = (t == nt - 2);
            const char* a1 = cA + (size_t)(t + 1) * kstep;
            const char* a2 = last ? nA : cA + (size_t)(t + 2) * kstep; const char* b2 = last ? nB : cB + (size_t)(t + 2) * kstep;
            const char* a3 = a2 + kstep; const char* b3 = b2 + kstep;
            unsigned w0[2], w1[2];
#pragma unroll
            for (int i = 0; i < 2; ++i) { w0[i] = vA0[i]; w1[i] = vA1[i]; }
            if constexpr (Sched::GATHER) { if (last) { asm volatile("" ::: "memory");
#pragma unroll
                for (int i = 0; i < 2; ++i) { w0[i] = nA0[i]; w1[i] = nA1[i]; } } }
            if (last && has_next) S.a_ready(nxt);
            if constexpr (SP2) {
            PG8_LDB(B0, 0, 0); PG8_LDB(B1, 0, 1); PG8_SCHED; PG8_LDA(At, 0, 0); PG8_STAGE(PG8_SA(1, 1), a1, vA1);
            PG8_WAIT_V(8); PG8_WAIT_L(0); PG8_BAR; PG8_MMA(0, 0, At, B0); PG8_MMA(0, 1, At, B1); PG8_BAR; PG8_SCHED;
            PG8_LDA(At, 0, 1); PG8_STAGE(PG8_SB(0, 0), b2, voffB); PG8_STAGE(PG8_SB(0, 1), b2 + hstepB, voffB); PG8_STAGE(PG8_SA(0, 0), a2, w0);
            PG8_WAIT_V(8); PG8_WAIT_L(0); PG8_BAR; PG8_MMA(1, 0, At, B0); PG8_MMA(1, 1, At, B1); PG8_BAR; PG8_SCHED;
            PG8_LDB(B0, 1, 0); PG8_LDB(B1, 1, 1); PG8_SCHED; PG8_LDA(At, 1, 0); PG8_STAGE(PG8_SA(0, 1), a2, w1);
            PG8_WAIT_V(8); PG8_WAIT_L(0); PG8_BAR; PG8_MMA(0, 0, At, B0); PG8_MMA(0, 1, At, B1); PG8_BAR; PG8_SCHED;
            PG8_LDA(At, 1, 1); PG8_STAGE(PG8_SB(1, 0), b3, voffB); PG8_STAGE(PG8_SB(1, 1), b3 + hstepB, voffB); PG8_STAGE(PG8_SA(1, 0), a3, w0);
            PG8_WAIT_V(8); PG8_WAIT_L(0); PG8_BAR; PG8_MMA(1, 0, At, B0); PG8_MMA(1, 1, At, B1); PG8_BAR; PG8_SCHED;
            } else {
            PG8_LDB(B0, 0, 0); PG8_SCHED; PG8_LDA(At, 0, 0); PG8_STAGE(PG8_SA(1, 1), a1, vA1);
            PG8_WAIT_L(8); PG8_BAR; PG8_WAIT_L(0); PG8_MMA(0, 0, At, B0); PG8_BAR; PG8_SCHED;
            PG8_LDB(B1, 0, 1); PG8_STAGE(PG8_SB(0, 0), b2, voffB);
            PG8_BAR; PG8_WAIT_L(0); PG8_MMA(0, 1, At, B1); PG8_BAR;
            PG8_LDA(At, 0, 1); PG8_STAGE(PG8_SA(0, 0), a2, w0);
            PG8_BAR; PG8_WAIT_L(0); PG8_MMA(1, 0, At, B0); PG8_BAR; PG8_SCHED;
            PG8_STAGE(PG8_SB(0, 1), b2 + hstepB, voffB);
            PG8_WAIT_V(6); PG8_BAR; PG8_MMA(1, 1, At, B1); PG8_BAR;
            PG8_LDB(B0, 1, 0); PG8_SCHED; PG8_LDA(At, 1, 0); PG8_STAGE(PG8_SA(0, 1), a2, w1);
            PG8_WAIT_L(8); PG8_BAR; PG8_WAIT_L(0); PG8_MMA(0, 0, At, B0); PG8_BAR; PG8_SCHED;
            PG8_LDB(B1, 1, 1); PG8_STAGE(PG8_SB(1, 0), b3, voffB);
            PG8_BAR; PG8_WAIT_L(0); PG8_MMA(0, 1, At, B1); PG8_BAR;
            PG8_LDA(At, 1, 1); PG8_STAGE(PG8_SA(1, 0), a3, w0);
            PG8_BAR; PG8_WAIT_L(0); PG8_MMA(1, 0, At, B0); PG8_BAR; PG8_SCHED;
            PG8_STAGE(PG8_SB(1, 1), b3 + hstepB, voffB);
            PG8_WAIT_V(6); PG8_BAR; PG8_MMA(1, 1, At, B1); PG8_BAR;
            }
        }
        if constexpr (ALIGN_EPI) { if (wr == 0) PG8_BAR; }
        if constexpr (!Epi::AFTER_DRAIN) { E(acc, cur, wr, wc, fr, fq); S.done(cur); }
        if (!has_next) break;
#pragma unroll
        for (int a = 0; a < 2; ++a)
#pragma unroll
            for (int b = 0; b < 2; ++b)
#pragma unroll
                for (int m = 0; m < 4; ++m)
#pragma unroll
                    for (int n = 0; n < 2; ++n) acc[a][b][m][n] = (f32x4){0.f, 0.f, 0.f, 0.f};
        cur = nxt; cA = nA; cB = nB; ++ui;
        if constexpr (Sched::GATHER) {
#pragma unroll
            for (int i = 0; i < 2; ++i) { vA0[i] = nA0[i]; vA1[i] = nA1[i]; } }
        if constexpr (ALIGN_EPI) { if (wr == 1) PG8_BAR; }
    }
    PG8_WAIT_V(0);
    if constexpr (!ALIGN_EPI) { if (wr == 0) PG8_BAR; }
    PG8_BAR;
    if constexpr (Epi::AFTER_DRAIN) { E.fused(acc, cur, wr, wc, fr, fq, lds, wid, lane); S.done(cur); }
#undef PG8_SA
#undef PG8_GATHER
#undef PG8_SB
#undef PG8_STAGE
#undef PG8_LDA
#undef PG8_LDB
#undef PG8_MMA
#undef PG8_WAIT_V
#undef PG8_WAIT_L
#undef PG8_BAR
#undef PG8_SCHED
}
}
struct Frame {
    LAS unsigned char* lds; unsigned char* ws; const float* const* in; float* out;
    int tid, lane, wave, bid, G;
};
#define LDS_WAIT() asm volatile("s_waitcnt lgkmcnt(0)" ::: "memory")
enum { I_X = 0, I_C, I_CTX, I_CCTX, I_MODW, I_MODB, I_N1W, I_N2W, I_WIN, I_BIN, I_HGLB, I_HGNW, I_S5LR, I_S5LI, I_S5DT, I_S5BR, I_S5BI, I_S5CR, I_S5CI, I_S5D, I_S5GW, I_S5GB,
       I_LQ1, I_LK1, I_LQ2, I_LK2, I_DANW, I_MLNW, I_WOUT, I_RTW, I_W1, I_W3, I_W2, I_FNW, N_IN };

DI int mod_idx(int row) { return row < NLAT ? (row >> 11) : 16; }
DI int seq_row(int b, int d, int p) {
    if (p < NC) return NLAT + b * NC + (d ? (NC - 1 - p) : p);
    const int t = p - NC; return b * NL + (d ? (NL - 1 - t) : t);
}
DI int xs_row(int e, int s, int j, int MT) { return s < 16 ? (e * MT + s) * 256 + j : (e * MT + 16 + ((s - 16) >> 3)) * 256 + ((s - 16) & 7) * 32 + j; }

DI float reduce16(float (&v)[16], int lane) {
#pragma unroll
    for (int i = 0; i < 8; ++i) { const bool hi = (lane & 32) != 0; const float keep = hi ? v[i + 8] : v[i], send = hi ? v[i] : v[i + 8]; v[i] = keep + __shfl_xor(send, 32); }
#pragma unroll
    for (int i = 0; i < 4; ++i) { const bool hi = (lane & 16) != 0; const float keep = hi ? v[i + 4] : v[i], send = hi ? v[i] : v[i + 4]; v[i] = keep + __shfl_xor(send, 16); }
#pragma unroll
    for (int i = 0; i < 2; ++i) { const bool hi = (lane & 8) != 0; const float keep = hi ? v[i + 2] : v[i], send = hi ? v[i] : v[i + 2]; v[i] = keep + __shfl_xor(send, 8); }
    const bool hi = (lane & 4) != 0; const float keep = hi ? v[1] : v[0], send = hi ? v[0] : v[1];
    float r = keep + __shfl_xor(send, 4);
    r += __shfl_xor(r, 2); r += __shfl_xor(r, 1);
    return r;
}

constexpr size_t WS_S5 = WS_T2;
constexpr size_t WS_S5A = WS_S5;
constexpr size_t WS_S5B = WS_S5 + 4 * MiB;
constexpr size_t WS_S5P = WS_S5 + 12 * MiB;
constexpr size_t WS_ACAT = WS_S5 + 13 * MiB;
constexpr size_t WS_XLOC = WS_S5 + 49 * MiB;
constexpr int NCHK = NTOK / 16;
DI void s5_tables_job(const Frame& F, int job8) {
    const int job = job8 >> 3, part = job8 & 7, li = job >> 4, g = job & 15;
    LAS f32x2* apw = (LAS f32x2*)F.lds;
    LAS f32x2* Bt = apw + 2 * 64 * 17;
    LAS f32x2* Cc = Bt + 2 * 64 * 16;
    LAS float* Kt = (LAS float*)(Cc + 16 * 64);
    if (F.tid < 128) {
        const int d = F.tid >> 6, p = F.tid & 63;
        const float lr = F.in[I_S5LR][((li * 2 + d) * 16 + g) * 64 + p], lim = F.in[I_S5LI][((li * 2 + d) * 16 + g) * 64 + p], dt = expf(F.in[I_S5DT][(li * 2 + d) * 16 + g]);
        const float mag = expf(lr * dt), ar = mag * cosf(lim * dt), ai = mag * sinf(lim * dt), den = lr * lr + lim * lim;
        const float cor = ((ar - 1.0f) * lr + ai * lim) / den, coi = (ai * lr - (ar - 1.0f) * lim) / den;
        float pr = 1.0f, pi = 0.0f;
        for (int tau = 0; tau <= 16; ++tau) { apw[(d * 64 + p) * 17 + tau] = (f32x2){pr, pi}; const float nr = pr * ar - pi * ai, ni = pr * ai + pi * ar; pr = nr; pi = ni; }
        for (int c = 0; c < 16; ++c) { const float xr = F.in[I_S5BR][((li * 16 + g) * 64 + p) * 16 + c], xi = F.in[I_S5BI][((li * 16 + g) * 64 + p) * 16 + c]; Bt[(d * 64 + p) * 16 + c] = (f32x2){cor * xr - coi * xi, cor * xi + coi * xr}; }
        if (part == 0) ((f32x2*)(F.ws + WS_S5P))[((li * 16 + g) * 2 + d) * 64 + p] = apw[(d * 64 + p) * 17 + 16];
    }
    for (int i = F.tid; i < 1024; i += NTHR) Cc[i] = (f32x2){F.in[I_S5CR][(li * 16 + g) * 1024 + i], F.in[I_S5CI][(li * 16 + g) * 1024 + i]};
    __syncthreads();
    for (int i = F.tid; i < 512; i += NTHR) {
        const int d = i >> 8, tau = (i >> 4) & 15, c = i & 15;
        if (d == 0 ? tau > 2 * part + 1 : tau > 15 - 2 * part) continue;
        float sk[16];
#pragma unroll
        for (int c2 = 0; c2 < 16; ++c2) sk[c2] = 0.f;
        for (int p = 0; p < 64; ++p) { const f32x2 C = Cc[c * 64 + p], P = apw[(d * 64 + p) * 17 + tau];
            const float wr = C.x * P.x - C.y * P.y, wi = C.x * P.y + C.y * P.x;
#pragma unroll
            for (int c2 = 0; c2 < 16; c2 += 2) { const f32x4 B2 = *(const LAS f32x4*)(Bt + (d * 64 + p) * 16 + c2); sk[c2] += wr * B2[0] - wi * B2[1]; sk[c2 + 1] += wr * B2[2] - wi * B2[3]; } }
#pragma unroll
        for (int c2 = 0; c2 < 16; ++c2) Kt[i * 16 + c2] = sk[c2];
    }
    __syncthreads();
    bf16_t* BA = (bf16_t*)(F.ws + WS_S5A) + (size_t)job * 256 * 256; bf16_t* BB = (bf16_t*)(F.ws + WS_S5B) + (size_t)job * 256 * 512;
    for (int i = part * 8192 + F.tid; i < (part + 1) * 8192; i += NTHR) {
        const int n = i >> 8, k = i & 255, d = n >> 7, p = (n & 127) >> 1, ri = n & 1, s = k >> 4, c2 = k & 15, e = d == 0 ? 15 - s : s;
        const f32x2 P = apw[(d * 64 + p) * 17 + e], B = Bt[(d * 64 + p) * 16 + c2];
        BA[i] = (bf16_t)f2bf(ri == 0 ? P.x * B.x - P.y * B.y : P.x * B.y + P.y * B.x);
    }
    for (int i = part * 16384 + F.tid; i < (part + 1) * 16384; i += NTHR) {
        const int n = i >> 9, k = i & 511, t = n >> 4, c = n & 15; float v;
        if (k < 256) { const int s = k >> 4, c2 = k & 15; v = 0.f; if (s <= t) v += Kt[((0 * 16 + (t - s)) * 16 + c) * 16 + c2]; if (s >= t) v += Kt[((1 * 16 + (s - t)) * 16 + c) * 16 + c2]; }
        else { const int kk = k - 256, d = kk >> 7, p = (kk & 127) >> 1, ri = kk & 1, e = d == 0 ? t + 1 : 16 - t;
            const f32x2 C = Cc[c * 64 + p], P = apw[(d * 64 + p) * 17 + e]; const float wr = C.x * P.x - C.y * P.y, wi = C.x * P.y + C.y * P.x; v = ri == 0 ? wr : -wi; }
        BB[i] = (bf16_t)f2bf(v);
    }
    __syncthreads();
}
DI int s5_chunk_at(int d, int b, int ci) { return ci < 16 ? 2048 + b * 16 + (d ? 15 - ci : ci) : b * 128 + (d ? 127 - (ci - 16) : ci - 16); }
DI void s5_carry_item(const Frame& F, int li, int idx) {
    const int p = idx & 63, d = (idx >> 6) & 1, g = (idx >> 7) & 15, b = idx >> 11;
    const f32x2 a16 = ((const f32x2*)(F.ws + WS_S5P))[((li * 16 + g) * 2 + d) * 64 + p];
    const unsigned* xl = (const unsigned*)(F.ws + WS_XLOC) + (size_t)g * NCHK * 128 + d * 64 + p;
    unsigned* x0 = (unsigned*)(F.ws + WS_ACAT) + (size_t)g * NCHK * 256 + 128 + d * 64 + p;
    float xr = 0.f, xi = 0.f;
#pragma unroll 1
    for (int blk = 0; blk < 4; ++blk) {
        unsigned v[36];
#pragma unroll
        for (int j = 0; j < 36; ++j) v[j] = xl[(size_t)s5_chunk_at(d, b, blk * 36 + j) * 128];
#pragma unroll
        for (int j = 0; j < 36; ++j) { x0[(size_t)s5_chunk_at(d, b, blk * 36 + j) * 256] = pg8::cvt_pk_nv(xr, xi);
            const float nr = a16.x * xr - a16.y * xi + bflo(v[j]), ni = a16.x * xi + a16.y * xr + bfhi(v[j]); xr = nr; xi = ni; }
    }
}
struct S5Order {
    static constexpr bool GATHER = false; DI const int* row_tab(const pg8::Unit&) const { return nullptr; }
    int G, c; const char* A; const char* B; size_t ga, gb, ta; int per = 9, nu = 144;
    __device__ bool next(int i, pg8::Unit& u) const { const long L = (long)i * G + c; if (L >= nu) return false; u.g = (int)(L / per); u.pm = (int)(L % per); u.pn = 0; return true; }
    DI const char* a_ptr(const pg8::Unit& u) const { return A + (size_t)u.g * ga + (size_t)u.pm * ta; }
    DI const char* b_ptr(const pg8::Unit& u) const { return B + (size_t)u.g * gb; }
    DI void a_ready(const pg8::Unit&) const {}
    DI void done(const pg8::Unit&) const {}
};
struct EpiS5A {
    static constexpr bool PERM = true, AFTER_DRAIN = false;
    bf16_t* X;
    DI void operator()(const f32x4 (&acc)[2][2][4][2], const pg8::Unit& u, int wr, int wc, int fr, int fq) const {
#pragma unroll
        for (int ai = 0; ai < 2; ++ai)
#pragma unroll
            for (int m = 0; m < 4; ++m) { const int row = u.pm * 256 + wr * 64 + fr + ai * 128 + m * 16;
#pragma unroll
                for (int bj = 0; bj < 2; ++bj) { const f32x4 v0 = acc[ai][bj][m][0], v1 = acc[ai][bj][m][1];
                    u32x4 w; w.x = pg8::cvt_pk_nv(v0[0], v0[1]); w.y = pg8::cvt_pk_nv(v0[2], v0[3]); w.z = pg8::cvt_pk_nv(v1[0], v1[1]); w.w = pg8::cvt_pk_nv(v1[2], v1[3]);
                    *(u32x4*)(X + ((size_t)u.g * NCHK + row) * 256 + bj * 128 + wc * 32 + 8 * fq) = w; } }
    }
};
DI float gelu_tanh_(float x) { const float t = 0.7978845608028654f * (x + 0.044715f * x * x * x); const float e = __expf(2.0f * t); return x * (1.0f - __builtin_amdgcn_rcpf(e + 1.0f)); }
struct EpiS5B {
    static constexpr bool PERM = true, AFTER_DRAIN = false;
    const bf16_t* Acat; const float* dsk; bf16_t* mix;
    DI void operator()(const f32x4 (&acc)[2][2][4][2], const pg8::Unit& u, int wr, int wc, int fr, int fq) const {
        const int chunk0 = u.pm * 256 + wr * 64 + fr;
        auto ld = [&](int k) { const int bj = k >> 3, ai = (k >> 2) & 1, m = k & 3; return *(const u32x4*)(Acat + ((size_t)u.g * NCHK + chunk0 + ai * 128 + m * 16) * 512 + bj * 128 + wc * 32 + 8 * fq); };
        u32x4 uc = ld(0), un = uc;
#pragma unroll
        for (int k = 0; k < 16; ++k) {
            const int bj = k >> 3, ai = (k >> 2) & 1, m = k & 3;
            if (k < 15) un = ld(k + 1);
            const int cr = bj * 128 + wc * 32 + 8 * fq, t = cr >> 4, c = cr & 15;
            const f32x4 d0 = *(const f32x4*)(dsk + u.g * 16 + c), d1 = *(const f32x4*)(dsk + u.g * 16 + c + 4);
            const int chunk = chunk0 + ai * 128 + m * 16; const u32x4 uw = uc;
            const f32x4 y0 = acc[ai][bj][m][0], y1 = acc[ai][bj][m][1];
            const float v0 = gelu_tanh_(y0[0] + d0[0] * bflo(uw.x)), v1 = gelu_tanh_(y0[1] + d0[1] * bfhi(uw.x)), v2 = gelu_tanh_(y0[2] + d0[2] * bflo(uw.y)), v3 = gelu_tanh_(y0[3] + d0[3] * bfhi(uw.y));
            const float v4 = gelu_tanh_(y1[0] + d1[0] * bflo(uw.z)), v5 = gelu_tanh_(y1[1] + d1[1] * bfhi(uw.z)), v6 = gelu_tanh_(y1[2] + d1[2] * bflo(uw.w)), v7 = gelu_tanh_(y1[3] + d1[3] * bfhi(uw.w));
            u32x4 w; w.x = pg8::cvt_pk_bf16(v0, v1); w.y = pg8::cvt_pk_bf16(v2, v3); w.z = pg8::cvt_pk_bf16(v4, v5); w.w = pg8::cvt_pk_bf16(v6, v7);
            *(u32x4*)(mix + (size_t)(chunk * 16 + t) * D + 256 + u.g * 16 + c) = w;
            uc = un;
        }
    }
};
struct EpiGLU {
    static constexpr bool PERM = true, AFTER_DRAIN = false;
    bf16_t* mix; const float* gb;
    DI void operator()(const f32x4 (&acc)[2][2][4][2], const pg8::Unit& u, int wr, int wc, int fr, int fq) const {
        const int row0 = u.pm * 256 + wr * 64 + fr;
        auto ptr = [&](int k) { const int bj = k >> 3, ai = (k >> 2) & 1, m = k & 3; return mix + (size_t)(row0 + ai * 128 + m * 16) * D + 256 + bj * 128 + wc * 32 + 8 * fq; };
        u32x4 vc = *(const u32x4*)ptr(0), vn = vc;
#pragma unroll
        for (int k = 0; k < 16; ++k) {
            const int bj = k >> 3, ai = (k >> 2) & 1, m = k & 3;
            if (k < 15) vn = *(const u32x4*)ptr(k + 1);
            const int cr = bj * 128 + wc * 32 + 8 * fq; const f32x4 b0 = *(const f32x4*)(gb + cr), b1 = *(const f32x4*)(gb + cr + 4);
            const u32x4 vw = vc; const f32x4 y0 = acc[ai][bj][m][0] + b0, y1 = acc[ai][bj][m][1] + b1;
            u32x4 w; w.x = pg8::cvt_pk_bf16(bflo(vw.x) * sigmoidf_(y0[0]), bfhi(vw.x) * sigmoidf_(y0[1])); w.y = pg8::cvt_pk_bf16(bflo(vw.y) * sigmoidf_(y0[2]), bfhi(vw.y) * sigmoidf_(y0[3]));
            w.z = pg8::cvt_pk_bf16(bflo(vw.z) * sigmoidf_(y1[0]), bfhi(vw.z) * sigmoidf_(y1[1])); w.w = pg8::cvt_pk_bf16(bflo(vw.w) * sigmoidf_(y1[2]), bfhi(vw.w) * sigmoidf_(y1[3]));
            *(u32x4*)ptr(k) = w;
            vc = vn;
        }
    }
};
constexpr float QSCALE = 0.25503486f;
struct EpiInProj {
    static constexpr bool PERM = true, AFTER_DRAIN = false;
    bf16_t* Z; const float* bias; const float* rope; bf16_t* Acat;
    DI void operator()(const f32x4 (&acc)[2][2][4][2], const pg8::Unit& u, int wr, int wc, int fr, int fq) const {
        const int pn = u.pn, row0 = u.pm * 256 + wr * 64 + fr;
        const float scl = (pn == 0 || pn == 10) ? 0.125f : (pn == 6 ? QSCALE : 1.0f);
        const bool do_rope = (pn == 6 || pn == 7) && (u.pm < 128);
        f32x4 bv[2][2];
#pragma unroll
        for (int bj = 0; bj < 2; ++bj) { const int c0 = pn * 256 + bj * 128 + wc * 32 + 8 * fq; bv[bj][0] = *(const f32x4*)(bias + c0); bv[bj][1] = *(const f32x4*)(bias + c0 + 4); }
        auto rp_of = [&](int k) { return rope + ((size_t)((row0 + (k >> 2) * 128 + (k & 3) * 16) & 2047) * 16 + 4 * fq) * 2; };
        f32x4 r0 = {1.f, 0.f, 1.f, 0.f}, r1 = r0, q0 = r0, q1 = r0;
        if (do_rope) { const float* rp = rp_of(0); r0 = *(const f32x4*)rp; r1 = *(const f32x4*)(rp + 4); }
#pragma unroll
        for (int k = 0; k < 8; ++k) {
            const int ai = k >> 2, m = k & 3, row = row0 + ai * 128 + m * 16;
            if (do_rope && k < 7) { const float* rp = rp_of(k + 1); q0 = *(const f32x4*)rp; q1 = *(const f32x4*)(rp + 4); }
#pragma unroll
            for (int bj = 0; bj < 2; ++bj) {
                const int c0 = pn * 256 + bj * 128 + wc * 32 + 8 * fq;
                f32x4 v0 = acc[ai][bj][m][0] + bv[bj][0], v1 = acc[ai][bj][m][1] + bv[bj][1];
                if (do_rope) {
                    f32x4 w0, w1;
                    w0[0] = v0[0] * r0[0] - v0[1] * r0[1]; w0[1] = v0[0] * r0[1] + v0[1] * r0[0];
                    w0[2] = v0[2] * r0[2] - v0[3] * r0[3]; w0[3] = v0[2] * r0[3] + v0[3] * r0[2];
                    w1[0] = v1[0] * r1[0] - v1[1] * r1[1]; w1[1] = v1[0] * r1[1] + v1[1] * r1[0];
                    w1[2] = v1[2] * r1[2] - v1[3] * r1[3]; w1[3] = v1[2] * r1[3] + v1[3] * r1[2];
                    v0 = w0; v1 = w1;
                }
                v0 = v0 * scl; v1 = v1 * scl;
                u32x4 w; w.x = pg8::cvt_pk_bf16(v0[0], v0[1]); w.y = pg8::cvt_pk_bf16(v0[2], v0[3]); w.z = pg8::cvt_pk_bf16(v1[0], v1[1]); w.w = pg8::cvt_pk_bf16(v1[2], v1[3]);
                *(u32x4*)(Z + (size_t)row * ZC + c0) = w;
                if (pn == 5) { const int cr = bj * 128 + wc * 32 + 8 * fq; *(u32x4*)(Acat + ((size_t)(cr >> 4) * (NTOK / 16) + (row >> 4)) * 512 + (row & 15) * 16 + (cr & 15)) = w; }
            }
            r0 = q0; r1 = q1;
        }
    }
};
struct EpiOutProj {
    static constexpr bool PERM = true, AFTER_DRAIN = false;
    const float* res_lat; const float* res_ctx; const bf16_t* res_bf; bf16_t* out; const float* modg;
    DI void operator()(const f32x4 (&acc)[2][2][4][2], const pg8::Unit& u, int wr, int wc, int fr, int fq) const {
        const int row0 = u.pm * 256 + wr * 64 + fr, col0 = u.pn * 256 + wc * 32 + 8 * fq;
        const int s = (u.pm < 128) ? (u.pm >> 3) : 16;
        f32x4 gv[2][2];
#pragma unroll
        for (int bj = 0; bj < 2; ++bj)
#pragma unroll
            for (int n = 0; n < 2; ++n) gv[bj][n] = *(const f32x4*)(modg + (size_t)s * 6144 + col0 + bj * 128 + 4 * n);
        if (res_bf) {
            u32x4 rc[2], rn[2];
#pragma unroll
            for (int bj = 0; bj < 2; ++bj) rc[bj] = *(const u32x4*)(res_bf + (size_t)row0 * D + col0 + bj * 128);
#pragma unroll
            for (int k = 0; k < 8; ++k) {
                const int row = row0 + (k >> 2) * 128 + (k & 3) * 16;
                if (k < 7) { const int rnx = row0 + ((k + 1) >> 2) * 128 + ((k + 1) & 3) * 16;
#pragma unroll
                    for (int bj = 0; bj < 2; ++bj) rn[bj] = *(const u32x4*)(res_bf + (size_t)rnx * D + col0 + bj * 128); }
#pragma unroll
                for (int bj = 0; bj < 2; ++bj) { const u32x4 w0 = rc[bj];
                    const f32x4 r0 = (f32x4){bflo(w0.x), bfhi(w0.x), bflo(w0.y), bfhi(w0.y)}, r1 = (f32x4){bflo(w0.z), bfhi(w0.z), bflo(w0.w), bfhi(w0.w)};
                    const f32x4 v0 = r0 + gv[bj][0] * acc[k >> 2][bj][k & 3][0], v1 = r1 + gv[bj][1] * acc[k >> 2][bj][k & 3][1];
                    u32x4 w; w.x = pg8::cvt_pk_bf16(v0[0], v0[1]); w.y = pg8::cvt_pk_bf16(v0[2], v0[3]); w.z = pg8::cvt_pk_bf16(v1[0], v1[1]); w.w = pg8::cvt_pk_bf16(v1[2], v1[3]);
                    *(u32x4*)(out + (size_t)row * D + col0 + bj * 128) = w; }
                rc[0] = rn[0]; rc[1] = rn[1];
            }
            return;
        }
        const float* rbase = (u.pm < 128) ? res_lat + (size_t)row0 * D + col0 : res_ctx + (size_t)(row0 - NLAT) * D + col0;
        auto off = [&](int q) { return (size_t)((q >> 3) * 128 + ((q >> 1) & 3) * 16) * D + (q & 1) * 128; };
        f32x4 c0 = *(const f32x4*)(rbase), c1 = *(const f32x4*)(rbase + 4), n0 = c0, n1 = c1;
#pragma unroll
        for (int q = 0; q < 16; ++q) {
            const int ai = q >> 3, m = (q >> 1) & 3, bj = q & 1, row = row0 + ai * 128 + m * 16, c = col0 + bj * 128;
            if (q < 15) { const float* rp = rbase + off(q + 1); n0 = *(const f32x4*)rp; n1 = *(const f32x4*)(rp + 4); }
            const f32x4 v0 = c0 + gv[bj][0] * acc[ai][bj][m][0], v1 = c1 + gv[bj][1] * acc[ai][bj][m][1];
            u32x4 w; w.x = pg8::cvt_pk_bf16(v0[0], v0[1]); w.y = pg8::cvt_pk_bf16(v0[2], v0[3]); w.z = pg8::cvt_pk_bf16(v1[0], v1[1]); w.w = pg8::cvt_pk_bf16(v1[2], v1[3]);
            *(u32x4*)(out + (size_t)row * D + c) = w;
            c0 = n0; c1 = n1;
        }
    }
};
struct EpiSwiGLU {
    static constexpr bool PERM = true, AFTER_DRAIN = false;
    bf16_t* H; int MT;
    DI void operator()(const f32x4 (&acc)[2][2][4][2], const pg8::Unit& u, int wr, int wc, int fr, int fq) const {
        const int row0 = (u.g * MT + u.pm) * 256 + wr * 64 + fr, col = u.pn * 128 + wc * 32 + 8 * fq;
#pragma unroll
        for (int ai = 0; ai < 2; ++ai)
#pragma unroll
            for (int m = 0; m < 4; ++m) {
                const int row = row0 + ai * 128 + m * 16;
                float h[8];
#pragma unroll
                for (int n = 0; n < 2; ++n)
#pragma unroll
                    for (int j = 0; j < 4; ++j) { const float a = acc[ai][0][m][n][j], b = acc[ai][1][m][n][j]; h[n * 4 + j] = a * __builtin_amdgcn_rcpf(1.0f + __expf(-a)) * b; }
                u32x4 w; w.x = pg8::cvt_pk_bf16(h[0], h[1]); w.y = pg8::cvt_pk_bf16(h[2], h[3]); w.z = pg8::cvt_pk_bf16(h[4], h[5]); w.w = pg8::cvt_pk_bf16(h[6], h[7]);
                *(u32x4*)(H + (size_t)row * DE + col) = w;
            }
    }
};
struct EpiDown {
    static constexpr bool PERM = true, AFTER_DRAIN = false;
    bf16_t* Y; const float* gate; int MT;
    DI void operator()(const f32x4 (&acc)[2][2][4][2], const pg8::Unit& u, int wr, int wc, int fr, int fq) const {
        const int row0 = (u.g * MT + u.pm) * 256 + wr * 64 + fr, col0 = u.pn * 256 + wc * 32 + 8 * fq;
        float gtv[8];
#pragma unroll
        for (int k = 0; k < 8; ++k) gtv[k] = gate[row0 + (k >> 2) * 128 + (k & 3) * 16];
#pragma unroll
        for (int ai = 0; ai < 2; ++ai)
#pragma unroll
            for (int m = 0; m < 4; ++m) {
                const int row = row0 + ai * 128 + m * 16; const float gt = gtv[ai * 4 + m];
#pragma unroll
                for (int bj = 0; bj < 2; ++bj) {
                    const f32x4 v0 = acc[ai][bj][m][0] * gt, v1 = acc[ai][bj][m][1] * gt;
                    u32x4 w; w.x = pg8::cvt_pk_bf16(v0[0], v0[1]); w.y = pg8::cvt_pk_bf16(v0[2], v0[3]); w.z = pg8::cvt_pk_bf16(v1[0], v1[1]); w.w = pg8::cvt_pk_bf16(v1[2], v1[3]);
                    *(u32x4*)(Y + (size_t)row * D + col0 + bj * 128) = w;
                }
            }
    }
};
DI void transpose_item(const float* W, int ldw, int k0, int n0, bf16_t* WT, size_t drow0, int ldk, LAS float* scr, int lane) {
    float tv[32];
#pragma unroll
    for (int i = 0; i < 32; ++i) tv[i] = W[(size_t)(k0 + 2 * i + (lane >> 5)) * ldw + n0 + (lane & 31)];
#pragma unroll
    for (int i = 0; i < 32; ++i) scr[(2 * i + (lane >> 5)) * 33 + (lane & 31)] = tv[i];
    LDS_WAIT();
    const int c = lane & 7;
#pragma unroll
    for (int j = 0; j < 4; ++j) { const int n = (lane >> 3) + 8 * j; const LAS float* s = scr + (8 * c) * 33 + n;
        u32x4 o; o.x = pg8::cvt_pk_nv(s[0 * 33], s[1 * 33]); o.y = pg8::cvt_pk_nv(s[2 * 33], s[3 * 33]); o.z = pg8::cvt_pk_nv(s[4 * 33], s[5 * 33]); o.w = pg8::cvt_pk_nv(s[6 * 33], s[7 * 33]);
        *(u32x4*)(WT + (drow0 + n) * (size_t)ldk + k0 + 8 * c) = o; }
    LDS_WAIT();
}
constexpr int IT_WIN = 16 * 104, IT_WOUT = 16 * 32, IT_EXP = 3072, IT_GLU = 32;
DI void dense_weight_item(const Frame& F, int it, LAS float* scr) {
    if (it < 2 * IT_WIN) { const int li = it / IT_WIN, r = it % IT_WIN, kb = r / 104, nb = r % 104;
        transpose_item(F.in[I_WIN] + (size_t)li * D * INC, INC, 64 * kb, 32 * nb, (bf16_t*)(F.ws + WS_WIN) + (size_t)li * ZC * D, 32 * nb, D, scr, F.lane); return; }
    it -= 2 * IT_WIN;
    if (it < 2 * IT_WOUT) { const int li = it / IT_WOUT, r = it % IT_WOUT, kb = r / 32, nb = r % 32;
        transpose_item(F.in[I_WOUT] + (size_t)li * D * D, D, 64 * kb, 32 * nb, (bf16_t*)(F.ws + WS_WOUT) + (size_t)li * D * D, 32 * nb, D, scr, F.lane); return; }
    it -= 2 * IT_WOUT;
    { const int li = it / IT_GLU, r = it % IT_GLU, kb = r / 8, nb = r % 8;
        transpose_item(F.in[I_S5GW] + (size_t)li * 256 * 256, 256, 64 * kb, 32 * nb, (bf16_t*)(F.ws + WS_GLUW) + (size_t)li * 256 * 256, 32 * nb, 256, scr, F.lane); }
}
DI void expert_weight_item(const Frame& F, int le, int it, LAS float* scr) {
    const int e = it / IT_EXP; int r = it % IT_EXP;
    if (r < 2048) { const int w3 = r >= 1024; r &= 1023; const int kb = r / 64, nb = r % 64, n0 = 32 * nb;
        transpose_item(F.in[w3 ? I_W3 : I_W1] + (size_t)(le * NE + e) * D * DE, DE, 64 * kb, n0, (bf16_t*)(F.ws + WS_W13) + (size_t)e * 4096 * D, (size_t)(n0 >> 7) * 256 + (n0 & 127) + (w3 ? 128 : 0), D, scr, F.lane); return; }
    r -= 2048; { const int kb = r / 32, nb = r % 32;
        transpose_item(F.in[I_W2] + (size_t)(le * NE + e) * DE * D, D, 64 * kb, 32 * nb, (bf16_t*)(F.ws + WS_W2) + (size_t)e * D * DE, 32 * nb, DE, scr, F.lane); }
}

struct TrDesc { const float* W; int ldw, k0, n0; bf16_t* WT; size_t drow0; int ldk; };
DI TrDesc expert_desc(const Frame& F, int le, int it) {
    const int e = it / IT_EXP; int r = it % IT_EXP;
    if (r < 2048) { const int w3 = r >= 1024; r &= 1023; const int kb = r / 64, nb = r % 64, n0 = 32 * nb;
        return TrDesc{F.in[w3 ? I_W3 : I_W1] + (size_t)(le * NE + e) * D * DE, DE, 64 * kb, n0, (bf16_t*)(F.ws + WS_W13) + (size_t)e * 4096 * D, (size_t)(n0 >> 7) * 256 + (n0 & 127) + (w3 ? 128 : 0), D}; }
    r -= 2048; const int kb = r / 32, nb = r % 32;
    return TrDesc{F.in[I_W2] + (size_t)(le * NE + e) * DE * D, D, 64 * kb, 32 * nb, (bf16_t*)(F.ws + WS_W2) + (size_t)e * D * DE, (size_t)(32 * nb), DE};
}
DI void tr_load(const TrDesc& t, int lane, float (&tv)[32]) {
#pragma unroll
    for (int i = 0; i < 32; ++i) tv[i] = t.W[(size_t)(t.k0 + 2 * i + (lane >> 5)) * t.ldw + t.n0 + (lane & 31)];
}
DI void tr_store(const TrDesc& t, const float (&tv)[32], LAS float* scr, int lane) {
#pragma unroll
    for (int i = 0; i < 32; ++i) scr[(2 * i + (lane >> 5)) * 33 + (lane & 31)] = tv[i];
    LDS_WAIT();
    const int c = lane & 7;
#pragma unroll
    for (int j = 0; j < 4; ++j) { const int n = (lane >> 3) + 8 * j; const LAS float* sp = scr + (8 * c) * 33 + n;
        u32x4 o; o.x = pg8::cvt_pk_nv(sp[0 * 33], sp[1 * 33]); o.y = pg8::cvt_pk_nv(sp[2 * 33], sp[3 * 33]); o.z = pg8::cvt_pk_nv(sp[4 * 33], sp[5 * 33]); o.w = pg8::cvt_pk_nv(sp[6 * 33], sp[7 * 33]);
        *(u32x4*)(t.WT + (t.drow0 + n) * (size_t)t.ldk + t.k0 + 8 * c) = o; }
    LDS_WAIT();
}
DI void phase_prologue(const Frame& F) {
    LAS float* sc = (LAS float*)F.lds;
    LAS float* scr = (LAS float*)(F.lds + 69632) + F.wave * (64 * 33);
    for (int job = F.bid; job < 256; job += F.G) s5_tables_job(F, job);
    __syncthreads();
    for (int i = F.tid; i < 17 * 1024; i += NTHR) { const float v = i < 16 * 1024 ? F.in[I_C][i] : F.in[I_CCTX][i - 16 * 1024]; sc[i] = siluf_(v); }
    __syncthreads();
    for (int job = F.bid; job < 192; job += F.G) {
        const int li = job / 96, n = (job % 96) * 64 + F.lane;
        const float* mw = F.in[I_MODW] + (size_t)li * D * 6144 + n;
        LAS float* red = (LAS float*)(F.lds + 69632);
        float acc[17];
#pragma unroll
        for (int s = 0; s < 17; ++s) acc[s] = 0.f;
        for (int k = 128 * F.wave; k < 128 * F.wave + 128; k += 16) {
            float w[16];
#pragma unroll
            for (int j = 0; j < 16; ++j) w[j] = mw[(size_t)(k + j) * 6144];
#pragma unroll
            for (int s = 0; s < 17; ++s) {
#pragma unroll
                for (int q = 0; q < 4; ++q) { const f32x4 c0 = *(const LAS f32x4*)(sc + s * 1024 + k + 4 * q); acc[s] += (c0[0] * w[4 * q] + c0[1] * w[4 * q + 1]) + (c0[2] * w[4 * q + 2] + c0[3] * w[4 * q + 3]); } }
        }
#pragma unroll
        for (int s = 0; s < 17; ++s) red[(F.wave * 17 + s) * 64 + F.lane] = acc[s];
        __syncthreads();
        for (int o = F.tid; o < 17 * 64; o += NTHR) { float v = 0.f;
#pragma unroll
            for (int w8 = 0; w8 < 8; ++w8) v += red[w8 * 17 * 64 + o];
            const int s = o >> 6, nn = (job % 96) * 64 + (o & 63);
            ((float*)(F.ws + WS_MOD))[((size_t)li * 17 + s) * 6144 + nn] = v + F.in[I_MODB][li * 6144 + nn]; }
        __syncthreads();
    }
    if (F.wave == 7) {
      for (int job = 192 + F.bid; job < 257; job += F.G) {
        if (job < 256) {
            float* rp = (float*)(F.ws + WS_ROPE);
            for (int i = 0; i < 8; ++i) { const int e = (job - 192) * 512 + F.lane + 64 * i; const int t = e >> 4, j = e & 15;
                const float pos = (float)(j < 8 ? (t >> 6) : (t & 63)), inv = expf(-9.210340371976184f * (float)(j & 7) * 0.125f), ang = pos * inv;
                rp[2 * e] = cosf(ang); rp[2 * e + 1] = sinf(ang); }
        } else {
            float* lb = (float*)(F.ws + WS_LB); const float* lg = F.in[I_HGLB];
            for (int i = F.lane; i < 1024; i += 64) { const int li = i >> 9, r = i & 511; lb[i] = li == 0 ? 0.f : sigmoidf_(lg[512 + r] - lg[r]); }
        }
      }
    }
    for (int i = F.bid * NTHR + F.tid; i < 4 * 16384; i += F.G * NTHR) {
        const int t = i >> 14, lw = t >> 1, kind = t & 1, e = i & 16383, k = e >> 4, jj = e & 15;
        const float val = kind == 0 ? F.in[I_WIN][((size_t)lw * D + k) * INC + ZC + jj] : F.in[I_RTW][((size_t)lw * D + k) * 16 + jj];
        ((float*)(F.ws + WS_WTG))[(size_t)t * 16384 + (k & 2) * 4096 + ((jj >> 1) * 256 + (k >> 2)) * 4 + (k & 1) * 2 + (jj & 1)] = val; }
    const int gw = F.bid * NWAVES + F.wave, NGW = F.G * NWAVES;
    for (int it = gw; it < 2 * IT_WIN + 2 * IT_WOUT + 2 * IT_GLU; it += NGW) dense_weight_item(F, it, scr);
    for (int it = gw; it < NE * IT_EXP; it += NGW) expert_weight_item(F, 0, it, scr);
}

DI void moe_combine(const Frame& F, int row, int MT, f32x4 (&acc)[4]) {
    const int s = row < NLAT ? (row >> 11) : 16 + ((row - NLAT) >> 8), t = row < NLAT ? (row & 2047) : ((row - NLAT) & 255);
    const int* inv = (const int*)(F.ws + WS_INV) + (size_t)s * 16 * 2048 + t;
    const bf16_t* Y = (const bf16_t*)(F.ws + WS_XS);
#pragma unroll
    for (int j = 0; j < 4; ++j) acc[j] = (f32x4){0.f, 0.f, 0.f, 0.f};
    const int jl = inv[(F.lane & 15) * 2048];
    unsigned hits = (unsigned)(__ballot(jl >= 0) & 0xffffull);
    while (hits) {
        const int e0 = __builtin_ctz(hits); hits &= hits - 1;
        const bool two = hits != 0u; const int e1 = two ? __builtin_ctz(hits) : e0; if (two) hits &= hits - 1;
        const bf16_t* y0 = Y + (size_t)xs_row(e0, s, __builtin_amdgcn_readlane(jl, e0), MT) * D + 4 * F.lane;
        const bf16_t* y1 = Y + (size_t)xs_row(e1, s, __builtin_amdgcn_readlane(jl, e1), MT) * D + 4 * F.lane;
        u32x2 w0[4], w1[4];
#pragma unroll
        for (int j = 0; j < 4; ++j) { w0[j] = *(const u32x2*)(y0 + 256 * j); w1[j] = *(const u32x2*)(y1 + 256 * j); }
#pragma unroll
        for (int j = 0; j < 4; ++j) { acc[j][0] += bflo(w0[j].x); acc[j][1] += bfhi(w0[j].x); acc[j][2] += bflo(w0[j].y); acc[j][3] += bfhi(w0[j].y); }
        if (two) {
#pragma unroll
            for (int j = 0; j < 4; ++j) { acc[j][0] += bflo(w1[j].x); acc[j][1] += bfhi(w1[j].x); acc[j][2] += bflo(w1[j].y); acc[j][3] += bfhi(w1[j].y); } }
    }
}

template <int KIND, bool CONV = false> DI int phase_norm(const Frame& F, int li, int npre = 0) {
    LAS float* WT = (LAS float*)F.lds;
    if (KIND != 2) {
        { const f32x4* src = (const f32x4*)(F.ws + WS_WTG) + (size_t)(li * 2 + KIND) * 4096;
          for (int i = F.tid; i < 4096; i += NTHR) ((LAS f32x4*)WT)[i] = src[i]; }
        __syncthreads();
    }
    const int gw = F.bid * NWAVES + F.wave, NGW = F.G * NWAVES;
    const int nrows = (KIND == 0 || li == 0) && KIND != 2 ? NTOK : NLAT;
    const float* modl = (const float*)(F.ws + WS_MOD) + (size_t)li * 17 * 6144;
    bf16_t* hl = (bf16_t*)(F.ws + WS_HL);
    bf16_t* xn = (bf16_t*)(F.ws + WS_XN);
    const float* nw = KIND == 0 ? F.in[I_N1W] + li * D : (KIND == 1 ? F.in[I_N2W] + li * D : F.in[I_FNW]);
    f32x4 vn[4];
    auto load_row = [&](int row) {
        if (KIND == 0 && li == 0) { const float* src = row < NLAT ? F.in[I_X] + (size_t)row * D : F.in[I_CTX] + (size_t)(row - NLAT) * D;
#pragma unroll
            for (int j = 0; j < 4; ++j) vn[j] = *(const f32x4*)(src + 4 * F.lane + 256 * j);
        } else {
#pragma unroll
            for (int j = 0; j < 4; ++j) { const u32x2 w = *(const u32x2*)(hl + (size_t)row * D + 4 * F.lane + 256 * j); vn[j] = (f32x4){bflo(w.x), bfhi(w.x), bflo(w.y), bfhi(w.y)}; }
        }
    };
    f32x4 nwv[4];
#pragma unroll
    for (int j = 0; j < 4; ++j) nwv[j] = *(const f32x4*)(nw + 4 * F.lane + 256 * j);
    if (gw < nrows) load_row(gw);
    int cit = gw; LAS float* cscr = (LAS float*)(F.lds + 65536) + F.wave * (64 * 33);
    for (int row = gw; row < nrows; row += NGW) {
        TrDesc cd{}; bool chave = false; float ctv[32];
        const int s = mod_idx(row);
        f32x4 v[4];
#pragma unroll
        for (int j = 0; j < 4; ++j) v[j] = vn[j];
        f32x4 scv[4], shv[4];
        if (KIND != 2) { const float* sh_ = modl + (size_t)s * 6144 + (KIND == 0 ? 0 : 3) * 1024;
#pragma unroll
            for (int j = 0; j < 4; ++j) { shv[j] = *(const f32x4*)(sh_ + 4 * F.lane + 256 * j); scv[j] = *(const f32x4*)(sh_ + 1024 + 4 * F.lane + 256 * j); } }
        if (KIND == 2 || (KIND == 0 && li > 0)) {
            const int lm = KIND == 2 ? DEPTH - 1 : li - 1; const float* g5 = (const float*)(F.ws + WS_MOD) + ((size_t)lm * 17 + s) * 6144 + 5 * 1024;
            f32x4 a[4]; moe_combine(F, row, lm == 0 ? 18 : 16, a);
#pragma unroll
            for (int j = 0; j < 4; ++j) { v[j] = v[j] + *(const f32x4*)(g5 + 4 * F.lane + 256 * j) * a[j]; if (KIND == 0) { u32x2 w; w.x = pg8::cvt_pk_bf16(v[j][0], v[j][1]); w.y = pg8::cvt_pk_bf16(v[j][2], v[j][3]); *(u32x2*)(hl + (size_t)row * D + 4 * F.lane + 256 * j) = w; } }
        }
        if (row + NGW < nrows) load_row(row + NGW);
        if (CONV) {
            while (cit < NE * IT_EXP && F.G == 256 && (cit % IT_EXP) < 2048 && (cit / IT_EXP) * 2048 + (cit % IT_EXP) < npre) cit += NGW;
            chave = cit < NE * IT_EXP; if (chave) { cd = expert_desc(F, li, cit); tr_load(cd, F.lane, ctv); cit += NGW; } }
        float ss = 0.f;
#pragma unroll
        for (int j = 0; j < 4; ++j) ss += (v[j][0] * v[j][0] + v[j][1] * v[j][1]) + (v[j][2] * v[j][2] + v[j][3] * v[j][3]);
        const float rstd = rsqrtf(wave_sum(ss) * (1.0f / D) + EPS);
        if (KIND == 2) {
#pragma unroll
            for (int j = 0; j < 4; ++j) *(f32x4*)(F.out + (size_t)row * D + 4 * F.lane + 256 * j) = v[j] * rstd * nwv[j];
            continue;
        }
        f32x2 p2[8];
#pragma unroll
        for (int jp = 0; jp < 8; ++jp) p2[jp] = (f32x2){0.f, 0.f};
#pragma unroll
        for (int j = 0; j < 4; ++j) {
            const int k = 4 * F.lane + 256 * j;
            const f32x4 y = v[j] * rstd * nwv[j] * (scv[j] + 1.0f) + shv[j];
            u32x2 w; w.x = pg8::cvt_pk_bf16(y[0], y[1]); w.y = pg8::cvt_pk_bf16(y[2], y[3]);
            *(u32x2*)(xn + (size_t)row * D + k) = w;
            f32x4 wa[8], wb[8];
#pragma unroll
            for (int jp = 0; jp < 8; ++jp) { wa[jp] = *(const LAS f32x4*)(WT + (jp * 256 + (k >> 2)) * 4); wb[jp] = *(const LAS f32x4*)(WT + 8192 + (jp * 256 + (k >> 2)) * 4); }
            __builtin_amdgcn_sched_barrier(0);
#pragma unroll
            for (int jp = 0; jp < 8; ++jp) {
                p2[jp] = p2[jp] + (f32x2){y[0], y[0]} * (f32x2){wa[jp][0], wa[jp][1]}; p2[jp] = p2[jp] + (f32x2){y[1], y[1]} * (f32x2){wa[jp][2], wa[jp][3]};
                p2[jp] = p2[jp] + (f32x2){y[2], y[2]} * (f32x2){wb[jp][0], wb[jp][1]}; p2[jp] = p2[jp] + (f32x2){y[3], y[3]} * (f32x2){wb[jp][2], wb[jp][3]}; }
        }
        float p[16];
#pragma unroll
        for (int jp = 0; jp < 8; ++jp) { p[2 * jp] = p2[jp][0]; p[2 * jp + 1] = p2[jp][1]; }
        const float r = reduce16(p, F.lane); const int o = F.lane >> 2;
        if (KIND == 0) { if ((F.lane & 3) == 0) ((float*)(F.ws + WS_ZG))[(size_t)row * 16 + o] = r + F.in[I_BIN][li * INC + ZC + o]; }
        else {
            float mx = r;
            mx = fmaxf(mx, dpp_perm(mx, 2)); mx = fmaxf(mx, dpp_perm(mx, 3));
            mx = fmaxf(fmaxf(row_lane(mx, 0), row_lane(mx, 16)), fmaxf(row_lane(mx, 32), row_lane(mx, 48)));
            const float ex = __expf(r - mx); float sm = ex;
            sm += dpp_perm(sm, 2); sm += dpp_perm(sm, 3);
            sm = (row_lane(sm, 0) + row_lane(sm, 16)) + (row_lane(sm, 32) + row_lane(sm, 48));
            const int sq = row < NLAT ? (row >> 11) : 16 + ((row - NLAT) >> 8), t = row < NLAT ? (row & 2047) : ((row - NLAT) & 255);
            if ((F.lane & 3) == 0) ((float*)(F.ws + WS_AFF))[((size_t)sq * 16 + o) * 2048 + t] = ex / sm;
        }
        if (CONV && chave) tr_store(cd, ctv, cscr, F.lane);
    }
    return cit;
}
DI float da_lambda(const Frame& F, int li, float& lam_init) {
    float s1 = 0.f, s2 = 0.f;
    for (int i = 0; i < 32; ++i) { s1 += F.in[I_LQ1][li * 32 + i] * F.in[I_LK1][li * 32 + i]; s2 += F.in[I_LQ2][li * 32 + i] * F.in[I_LK2][li * 32 + i]; }
    lam_init = li == 0 ? 0.2f : 0.35550907f;
    return expf(s1) - expf(s2) + lam_init;
}
constexpr int AT_RS = 144;
constexpr int AT_TILE = 64 * AT_RS;
DI void attn_unit(const Frame& F, int li, int unit, float lam, float lam_init) {
    const bool isctx = unit >= 512; const int uu = isctx ? unit - 512 : unit;
    const int b = isctx ? uu >> 2 : uu >> 5, h = isctx ? uu & 3 : (uu >> 3) & 3, qb = isctx ? 0 : uu & 7;
    const int fr = F.lane & 15, quad = F.lane >> 4;
    const int qrow0 = (isctx ? NLAT + b * NC : b * NL + qb * 256) + F.wave * 32;
    const int nkt = isctx ? 4 : 36;
    const bf16_t* Z = (const bf16_t*)(F.ws + WS_Z);
    bf16x8 qf[2][2];
#pragma unroll
    for (int qt = 0; qt < 2; ++qt)
#pragma unroll
        for (int m = 0; m < 2; ++m) qf[qt][m] = *(const bf16x8*)(Z + (size_t)(qrow0 + 16 * qt + fr) * ZC + Z_DAQ + h * 64 + m * 32 + 8 * quad);
    f32x4 O[4][2][2], LS[2][2];
#pragma unroll
    for (int dt = 0; dt < 4; ++dt)
#pragma unroll
        for (int qt = 0; qt < 2; ++qt)
#pragma unroll
            for (int m = 0; m < 2; ++m) O[dt][qt][m] = (f32x4){0.f, 0.f, 0.f, 0.f};
#pragma unroll
    for (int qt = 0; qt < 2; ++qt)
#pragma unroll
        for (int m = 0; m < 2; ++m) LS[qt][m] = (f32x4){0.f, 0.f, 0.f, 0.f};
    const bf16x8 ones = __builtin_bit_cast(bf16x8, (u32x4){0x3F803F80u, 0x3F803F80u, 0x3F803F80u, 0x3F803F80u});
    const int skey = F.tid >> 3, spiece = F.tid & 7;
    u32x4 kregA, vregA, kregB, vregB;
    auto load_tile = [&](int t, u32x4& kreg, u32x4& vreg) {
        const int kidx = t * 64 + skey; const int krow = kidx < NC ? NLAT + b * NC + kidx : b * NL + (kidx - NC);
        const bf16_t* zr = Z + (size_t)krow * ZC + h * 64 + spiece * 8;
        kreg = *(const u32x4*)(zr + Z_DAK); vreg = *(const u32x4*)(zr + Z_DAV);
    };
    auto store_tile = [&](int buf, const u32x4& kreg, const u32x4& vreg) {
        LAS unsigned char* kb = F.lds + buf * (2 * AT_TILE); LAS unsigned char* vb = kb + AT_TILE;
        *(LAS u32x4*)(kb + skey * AT_RS + spiece * 16) = kreg;
        const unsigned w[4] = {vreg.x, vreg.y, vreg.z, vreg.w};
        const int kro = ((skey + 4 * spiece) & 63) * 2;
#pragma unroll
        for (int i = 0; i < 4; ++i) { *(LAS unsigned short*)(vb + (spiece * 8 + 2 * i) * AT_RS + kro) = (unsigned short)(w[i] & 0xffffu); *(LAS unsigned short*)(vb + (spiece * 8 + 2 * i + 1) * AT_RS + kro) = (unsigned short)(w[i] >> 16); }
    };
    __syncthreads();
    { u32x4 k0, v0, k1, v1; load_tile(0, k0, v0); load_tile(1, k1, v1); load_tile(2, kregA, vregA); load_tile(3, kregB, vregB); store_tile(0, k0, v0); store_tile(1, k1, v1); }
    __syncthreads();
    f32x4 Sc0, Sc1; u32x4 Pp = (u32x4){0u, 0u, 0u, 0u};
    bf16x8 kfr[2], vf[4];
#pragma unroll
    for (int dt = 0; dt < 4; ++dt) vf[dt] = __builtin_bit_cast(bf16x8, (u32x4){0u, 0u, 0u, 0u});
    { const f32x4 z4 = {0.f, 0.f, 0.f, 0.f};
      kfr[0] = *(const LAS bf16x8*)(F.lds + (fr) * AT_RS + quad * 16); kfr[1] = *(const LAS bf16x8*)(F.lds + (16 + fr) * AT_RS + quad * 16);
      Sc0 = __builtin_amdgcn_mfma_f32_16x16x32_bf16(kfr[0], qf[0][0], z4, 0, 0, 0); Sc1 = __builtin_amdgcn_mfma_f32_16x16x32_bf16(kfr[1], qf[0][0], z4, 0, 0, 0); }
    auto load_v = [&](int j, int g, bf16x8 (&vf)[4]) {
        const LAS unsigned char* vb = F.lds + j * (2 * AT_TILE) + AT_TILE;
#pragma unroll
        for (int dt = 0; dt < 4; ++dt) { const int dvr = 16 * dt + fr, rot = 4 * (dvr >> 3); const LAS unsigned char* vrow = vb + dvr * AT_RS;
            const u32x2 lo = *(const LAS u32x2*)(vrow + ((32 * g + 4 * quad + rot) & 63) * 2), hi = *(const LAS u32x2*)(vrow + ((32 * g + 16 + 4 * quad + rot) & 63) * 2);
            vf[dt] = __builtin_bit_cast(bf16x8, (u32x4){lo.x, lo.y, hi.x, hi.y}); }
    };
#define AT_STEP(J, C) do { \
        constexpr int g_ = (C) >> 2, m_ = ((C) >> 1) & 1, qt_ = (C) & 1; (void)g_; (void)m_; \
        constexpr int pc_ = ((C) + 7) & 7, pm_ = (pc_ >> 1) & 1, pqt_ = pc_ & 1; \
        constexpr int nc_ = ((C) + 1) & 7, ng_ = nc_ >> 2, nm_ = (nc_ >> 1) & 1, nqt_ = nc_ & 1; (void)ng_; \
        const bf16x8 pp_ = __builtin_bit_cast(bf16x8, Pp); \
        float p_[8]; \
        p_[0] = __builtin_amdgcn_exp2f(Sc0[0]); p_[1] = __builtin_amdgcn_exp2f(Sc0[1]); \
        LS[pqt_][pm_] = __builtin_amdgcn_mfma_f32_16x16x32_bf16(ones, pp_, LS[pqt_][pm_], 0, 0, 0); \
        p_[2] = __builtin_amdgcn_exp2f(Sc0[2]); p_[3] = __builtin_amdgcn_exp2f(Sc0[3]); \
        O[0][pqt_][pm_] = __builtin_amdgcn_mfma_f32_16x16x32_bf16(vf[0], pp_, O[0][pqt_][pm_], 0, 0, 0); \
        p_[4] = __builtin_amdgcn_exp2f(Sc1[0]); p_[5] = __builtin_amdgcn_exp2f(Sc1[1]); \
        O[1][pqt_][pm_] = __builtin_amdgcn_mfma_f32_16x16x32_bf16(vf[1], pp_, O[1][pqt_][pm_], 0, 0, 0); \
        p_[6] = __builtin_amdgcn_exp2f(Sc1[2]); p_[7] = __builtin_amdgcn_exp2f(Sc1[3]); \
        O[2][pqt_][pm_] = __builtin_amdgcn_mfma_f32_16x16x32_bf16(vf[2], pp_, O[2][pqt_][pm_], 0, 0, 0); \
        u32x4 w_; w_.x = pg8::cvt_pk_nv(p_[0], p_[1]); w_.y = pg8::cvt_pk_nv(p_[2], p_[3]); \
        O[3][pqt_][pm_] = __builtin_amdgcn_mfma_f32_16x16x32_bf16(vf[3], pp_, O[3][pqt_][pm_], 0, 0, 0); \
        w_.z = pg8::cvt_pk_nv(p_[4], p_[5]); w_.w = pg8::cvt_pk_nv(p_[6], p_[7]); \
        if ((C) == 0) load_v((J), 0, vf); \
        if ((C) == 4) load_v((J), 1, vf); \
        { const f32x4 z4_ = {0.f, 0.f, 0.f, 0.f}; \
          Sc0 = __builtin_amdgcn_mfma_f32_16x16x32_bf16(kfr[0], qf[nqt_][nm_], z4_, 0, 0, 0); Sc1 = __builtin_amdgcn_mfma_f32_16x16x32_bf16(kfr[1], qf[nqt_][nm_], z4_, 0, 0, 0); } \
        if (qt_ == 0) { constexpr int c2_ = ((C) + 2) & 7, g2_ = c2_ >> 2, m2_ = (c2_ >> 1) & 1, j2_ = (C) == 6 ? ((J) + 1) & 3 : (J);     \
            const LAS unsigned char* kbn = F.lds + j2_ * (2 * AT_TILE); \
            kfr[0] = *(const LAS bf16x8*)(kbn + (16 * (2 * g2_) + fr) * AT_RS + m2_ * 64 + quad * 16); kfr[1] = *(const LAS bf16x8*)(kbn + (16 * (2 * g2_ + 1) + fr) * AT_RS + m2_ * 64 + quad * 16); } \
        Pp = w_; __builtin_amdgcn_sched_barrier(0); \
    } while (0)
#define AT_TILE_STEPS(J) do { AT_STEP(J, 0); AT_STEP(J, 1); AT_STEP(J, 2); AT_STEP(J, 3); AT_STEP(J, 4); AT_STEP(J, 5); AT_STEP(J, 6); AT_STEP(J, 7); } while (0)
    if (F.wave >= 4) __builtin_amdgcn_s_setprio(1);
    for (int t = 0; t < nkt; t += 4) {
        if (t + 2 < nkt) store_tile(2, kregA, vregA);
        if (t + 4 < nkt) load_tile(t + 4, kregA, vregA);
        AT_TILE_STEPS(0);
        __syncthreads();
        if (t + 3 < nkt) store_tile(3, kregB, vregB);
        if (t + 5 < nkt) load_tile(t + 5, kregB, vregB);
        AT_TILE_STEPS(1);
        __syncthreads();
        if (t + 4 < nkt) store_tile(0, kregA, vregA);
        if (t + 6 < nkt) load_tile(t + 6, kregA, vregA);
        AT_TILE_STEPS(2);
        __syncthreads();
        if (t + 5 < nkt) store_tile(1, kregB, vregB);
        if (t + 7 < nkt) load_tile(t + 7, kregB, vregB);
        AT_TILE_STEPS(3);
        __syncthreads();
    }
    __builtin_amdgcn_s_setprio(0);
    { const bf16x8 pp_ = __builtin_bit_cast(bf16x8, Pp);
      LS[1][1] = __builtin_amdgcn_mfma_f32_16x16x32_bf16(ones, pp_, LS[1][1], 0, 0, 0);
#pragma unroll
      for (int dt = 0; dt < 4; ++dt) O[dt][1][1] = __builtin_amdgcn_mfma_f32_16x16x32_bf16(vf[dt], pp_, O[dt][1][1], 0, 0, 0); }
#undef AT_STEP
#undef AT_TILE_STEPS
    const float* nw = F.in[I_DANW] + li * 256 + h * 64; bf16_t* mix = (bf16_t*)(F.ws + WS_MIX);
#pragma unroll
    for (int qt = 0; qt < 2; ++qt) {
        const float l0 = LS[qt][0][0], l1 = LS[qt][1][0];
        const float i0 = 1.0f / l0, i1 = lam / l1;
        f32x4 o[4]; float ss = 0.f;
#pragma unroll
        for (int dt = 0; dt < 4; ++dt) { o[dt] = O[dt][qt][0] * i0 - O[dt][qt][1] * i1; ss += (o[dt][0] * o[dt][0] + o[dt][1] * o[dt][1]) + (o[dt][2] * o[dt][2] + o[dt][3] * o[dt][3]); }
        ss += __shfl_xor(ss, 16); ss += __shfl_xor(ss, 32);
        const float rs = rsqrtf(ss * (1.0f / 64.0f) + EPS) * (1.0f - lam_init);
        bf16_t* mo = mix + (size_t)(qrow0 + 16 * qt + fr) * D + 512 + h * 64 + 4 * quad;
#pragma unroll
        for (int dt = 0; dt < 4; ++dt) { const f32x4 w4 = *(const f32x4*)(nw + 16 * dt + 4 * quad); u32x2 w; w.x = pg8::cvt_pk_bf16(o[dt][0] * rs * w4[0], o[dt][1] * rs * w4[1]); w.y = pg8::cvt_pk_bf16(o[dt][2] * rs * w4[2], o[dt][3] * rs * w4[3]);
            *(u32x2*)(mo + 16 * dt) = w; }
    }
}
constexpr size_t WS_SLOC_HG = WS_T0, WS_SLOC_ML = WS_T1;
constexpr size_t WS_SBF_HG = WS_XN, WS_SBF_ML = WS_XN + 36 * MiB;
constexpr size_t WS_HGP = 32 * MiB;
constexpr size_t WS_MLP = 34 * MiB;
constexpr size_t WS_MLN = 35 * MiB;
constexpr int CH_RS = 80;
DI int chunk_row0(int b, int tc) { return tc < 4 ? NLAT + b * NC + 64 * tc : b * NL + 64 * (tc - 4); }
DI int dir_chunk(int d, int c) { return d == 0 ? c : (c < 4 ? 3 - c : 39 - c); }
DI float logsigmoidf_(float x) { return fminf(x, 0.f) - log1pf(__expf(-fabsf(x))); }
DI float dir_scan(float v, int d, int lane) {
#pragma unroll
    for (int o = 1; o < 64; o <<= 1) { const float t = d == 0 ? __shfl_up(v, o) : __shfl_down(v, o); if (d == 0 ? lane >= o : lane + o < 64) v += t; }
    return v;
}
DI bf16x8 pack8(const float (&p)[8]) { u32x4 w; w.x = pg8::cvt_pk_nv(p[0], p[1]); w.y = pg8::cvt_pk_nv(p[2], p[3]); w.z = pg8::cvt_pk_nv(p[4], p[5]); w.w = pg8::cvt_pk_nv(p[6], p[7]); return __builtin_bit_cast(bf16x8, w); }

template <int RS> DI void stage_t32(const bf16_t* g, LAS unsigned char* img, int lane) {
    const bf16_t* src = g + (size_t)(lane >> 1) * ZC + (lane & 1) * 8;
    u32x4 w[4];
#pragma unroll
    for (int i = 0; i < 4; ++i) w[i] = *(const u32x4*)(src + 16 * i);
    LAS unsigned char* dst = img + (lane >> 1) * 2 + ((lane & 1) * 8) * RS;
#pragma unroll
    for (int i = 0; i < 4; ++i) { const unsigned ww[4] = {w[i].x, w[i].y, w[i].z, w[i].w};
#pragma unroll
        for (int jj = 0; jj < 4; ++jj) { *(LAS unsigned short*)(dst + (16 * i + 2 * jj) * RS) = (unsigned short)(ww[jj] & 0xffffu); *(LAS unsigned short*)(dst + (16 * i + 2 * jj + 1) * RS) = (unsigned short)(ww[jj] >> 16); } }
}
DI bf16x8 lds_frag64(const LAS unsigned char* p) { const u32x2 lo = *(const LAS u32x2*)p, hi = *(const LAS u32x2*)(p + 8); return __builtin_bit_cast(bf16x8, (u32x4){lo.x, lo.y, hi.x, hi.y}); }
constexpr int P1_RS = 72;
DI void mlstm_pass1(const Frame& F, int task) {
    const int c = task % 36, sq = task / 36, d = sq & 1, h = (sq >> 1) & 3, b = sq >> 3;
    const int row0 = chunk_row0(b, dir_chunk(d, c)), fr = F.lane & 15, quad = F.lane >> 4;
    LAS unsigned char* L = F.lds + F.wave * 16384; LAS unsigned char* KT = L; LAS unsigned char* VT = L + 64 * P1_RS; LAS float* wb = (LAS float*)(L + 2 * 64 * P1_RS);
    const bf16_t* Z = (const bf16_t*)(F.ws + WS_Z); const float* zg = (const float*)(F.ws + WS_ZG) + (size_t)(row0 + F.lane) * 16;
    const float xa = zg[d * 4 + h], lf = logsigmoidf_(zg[8 + d * 4 + h]);
    const float bs = dir_scan(lf, d, F.lane), bend = __shfl(bs, d == 0 ? 63 : 0);
    wb[F.lane] = __expf(bend - bs + xa);
    f32x4 acc[4][4];
#pragma unroll
    for (int i = 0; i < 4; ++i)
#pragma unroll
        for (int j = 0; j < 4; ++j) acc[i][j] = (f32x4){0.f, 0.f, 0.f, 0.f};
    float nacc = 0.f;
    const bf16_t* zc = Z + (size_t)row0 * ZC + h * 64;
#pragma unroll 1
    for (int half = 0; half < 2; ++half) {
        stage_t32<P1_RS>(zc + (size_t)(32 * half) * ZC + Z_MLK, KT, F.lane);
        stage_t32<P1_RS>(zc + (size_t)(32 * half) * ZC + Z_MLV, VT, F.lane);
        { LAS unsigned char* kr = KT + F.lane * P1_RS;
#pragma unroll
          for (int q = 0; q < 8; ++q) { u32x2 w = *(const LAS u32x2*)(kr + 8 * q); const f32x4 w4 = *(const LAS f32x4*)(wb + 32 * half + 4 * q);
              const float k0 = bflo(w.x) * w4[0], k1 = bfhi(w.x) * w4[1], k2 = bflo(w.y) * w4[2], k3 = bfhi(w.y) * w4[3]; nacc += (k0 + k1) + (k2 + k3);
              w.x = pg8::cvt_pk_bf16(k0, k1); w.y = pg8::cvt_pk_bf16(k2, k3); *(LAS u32x2*)(kr + 8 * q) = w; } }
        bf16x8 af[4], bfr[4];
#pragma unroll
        for (int i = 0; i < 4; ++i) { af[i] = lds_frag64(KT + (16 * i + fr) * P1_RS + quad * 16); bfr[i] = lds_frag64(VT + (16 * i + fr) * P1_RS + quad * 16); }
#pragma unroll
        for (int i = 0; i < 4; ++i)
#pragma unroll
            for (int j = 0; j < 4; ++j) acc[i][j] = __builtin_amdgcn_mfma_f32_16x16x32_bf16(af[i], bfr[j], acc[i][j], 0, 0, 0);
    }
    bf16_t* So = (bf16_t*)(F.ws + WS_SLOC_ML) + (size_t)task * 4096;
#pragma unroll
    for (int i = 0; i < 4; ++i)
#pragma unroll
        for (int j = 0; j < 4; ++j) { u32x2 w; w.x = pg8::cvt_pk_nv(acc[i][j][0], acc[i][j][1]); w.y = pg8::cvt_pk_nv(acc[i][j][2], acc[i][j][3]); *(u32x2*)(So + (16 * j + fr) * 64 + 16 * i + 4 * quad) = w; }
    ((float*)(F.ws + WS_MLN))[(size_t)task * 64 + F.lane] = nacc;
    if (F.lane == 0) ((float*)(F.ws + WS_MLP))[task] = __expf(bend);
}
template <bool PERCH> DI void carry_item(const bf16_t* sloc, const float* dec, bf16_t* sbf, int idx) {
    const int sq = idx >> 10, e = (idx & 1023) * 4;
    f32x4 S = (f32x4){0.f, 0.f, 0.f, 0.f};
#pragma unroll 1
    for (int c0 = 0; c0 < 36; c0 += 12) {
        u32x2 v[12]; f32x4 pd[12];
#pragma unroll
        for (int c = 0; c < 12; ++c) { v[c] = *(const u32x2*)(sloc + ((size_t)sq * 36 + c0 + c) * 4096 + e);
            if (PERCH) pd[c] = *(const f32x4*)(dec + ((size_t)sq * 36 + c0 + c) * 64 + (e & 63)); else { const float p1 = dec[sq * 36 + c0 + c]; pd[c] = (f32x4){p1, p1, p1, p1}; } }
#pragma unroll
        for (int c = 0; c < 12; ++c) {
            u32x2 w; w.x = pg8::cvt_pk_bf16(S[0], S[1]); w.y = pg8::cvt_pk_bf16(S[2], S[3]); *(u32x2*)(sbf + ((size_t)sq * 36 + c0 + c) * 4096 + e) = w;
            S = pd[c] * S + (f32x4){bflo(v[c].x), bfhi(v[c].x), bflo(v[c].y), bfhi(v[c].y)};
        }
    }
}
DI void carry_n_item(float* nb, const float* dec, int idx) {
    const int sq = idx >> 6, e = idx & 63;
    float v[36], dv[36];
#pragma unroll
    for (int c = 0; c < 36; ++c) { v[c] = nb[((size_t)sq * 36 + c) * 64 + e]; dv[c] = dec[sq * 36 + c]; }
    float S = 0.f;
#pragma unroll
    for (int c = 0; c < 36; ++c) { nb[((size_t)sq * 36 + c) * 64 + e] = S; S = dv[c] * S + v[c]; }
}
constexpr int VT_RS = 136;
constexpr int ML3_LDS = 8192 + 64 * 136 + 3 * 512;
constexpr size_t WS_MLO = WS_T1;
template <int d> DI void mlstm_dir(const Frame& F, int li, int bh, int tc, int row0, int fr, int quad,
                                   const LAS unsigned char* KI, const LAS unsigned char* VT, const LAS float* bb, const LAS float* ab, const LAS float* n0, f32x4* oscr, int ti_lo, int ti_hi) {
    const size_t st = (size_t)(bh * 2 + d) * 36 + dir_chunk(d, tc);
    const bf16_t* C0 = (const bf16_t*)(F.ws + WS_SBF_ML) + st * 4096;
    const int h = bh & 3;
    const bf16_t* zkq = (const bf16_t*)(F.ws + WS_Z) + (size_t)(row0 + fr) * ZC + h * 64 + 8 * quad;
    bf16x8 cf[4][2], qc[2];
    f32x4 nwv[4];
    if (d == 1) {
#pragma unroll
        for (int dvt = 0; dvt < 4; ++dvt) nwv[dvt] = *(const f32x4*)(F.in[I_MLNW] + li * 256 + h * 64 + 16 * dvt + 4 * quad); }
#pragma unroll
    for (int dvt = 0; dvt < 4; ++dvt)
#pragma unroll
        for (int ks = 0; ks < 2; ++ks) cf[dvt][ks] = *(const bf16x8*)(C0 + (16 * dvt + fr) * 64 + 32 * ks + 8 * quad);
#pragma unroll
    for (int ks = 0; ks < 2; ++ks) qc[ks] = *(const bf16x8*)(zkq + (size_t)(16 * ti_lo) * ZC + Z_MLQ + 32 * ks);
#pragma unroll 1
    for (int ti = ti_lo; ti < ti_hi; ++ti) {
        bf16x8 kf[4][2], qn[2];
#pragma unroll
        for (int si = 0; si < 4; ++si)
#pragma unroll
            for (int ks = 0; ks < 2; ++ks) kf[si][ks] = *(const LAS bf16x8*)(KI + (16 * si + fr) * 128 + (((4 * ks + quad) ^ ((fr >> 1) & 7)) * 16));
        { const int tn = ti < 3 ? ti + 1 : 3;
#pragma unroll
          for (int ks = 0; ks < 2; ++ks) qn[ks] = *(const bf16x8*)(zkq + (size_t)(16 * tn) * ZC + Z_MLQ + 32 * ks); }
        f32x4 pk[4]; u32x2 ozv[4];
        if (d == 1) { const bf16_t* zo = (const bf16_t*)(F.ws + WS_Z) + (size_t)(row0 + 16 * ti + fr) * ZC + Z_MLO + h * 64 + 4 * quad;
#pragma unroll
            for (int dvt = 0; dvt < 4; ++dvt) { pk[dvt] = oscr[(ti * 4 + dvt) * 64 + F.lane]; ozv[dvt] = *(const u32x2*)(zo + 16 * dvt); }
            __builtin_amdgcn_sched_barrier(0); }
        const float bt = bb[64 * d + 16 * ti + fr], ebt = __expf(bt);
        f32x4 num1[4], num2[4]; float den1 = 0.f, den2 = 0.f;
#pragma unroll
        for (int dvt = 0; dvt < 4; ++dvt) { num1[dvt] = (f32x4){0.f, 0.f, 0.f, 0.f}; num2[dvt] = (f32x4){0.f, 0.f, 0.f, 0.f}; }
#pragma unroll
        for (int ks = 0; ks < 2; ++ks) {
#pragma unroll
            for (int dvt = 0; dvt < 4; ++dvt) num2[dvt] = __builtin_amdgcn_mfma_f32_16x16x32_bf16(cf[dvt][ks], qc[ks], num2[dvt], 0, 0, 0);
            const f32x4 na = *(const LAS f32x4*)(n0 + 64 * d + 32 * ks + 8 * quad), nb2 = *(const LAS f32x4*)(n0 + 64 * d + 32 * ks + 8 * quad + 4);
            const u32x4 qw = __builtin_bit_cast(u32x4, qc[ks]);
            den2 += (bflo(qw.x) * na[0] + bfhi(qw.x) * na[1]) + (bflo(qw.y) * na[2] + bfhi(qw.y) * na[3]) + (bflo(qw.z) * nb2[0] + bfhi(qw.z) * nb2[1]) + (bflo(qw.w) * nb2[2] + bfhi(qw.w) * nb2[3]);
        }
        den2 += __shfl_xor(den2, 16); den2 += __shfl_xor(den2, 32);
#pragma unroll
        for (int g = 0; g < 2; ++g) {
            if (d == 0 ? (2 * g <= ti) : (2 * g + 1 >= ti)) {
                float p[8];
#pragma unroll
                for (int kk = 0; kk < 2; ++kk) {
                    const int si = 2 * g + kk;
                    f32x4 s4 = (f32x4){0.f, 0.f, 0.f, 0.f};
                    s4 = __builtin_amdgcn_mfma_f32_16x16x32_bf16(kf[si][0], qc[0], s4, 0, 0, 0);
                    s4 = __builtin_amdgcn_mfma_f32_16x16x32_bf16(kf[si][1], qc[1], s4, 0, 0, 0);
                    const f32x4 a4 = *(const LAS f32x4*)(ab + 64 * d + 16 * si + 4 * quad);
#pragma unroll
                    for (int j = 0; j < 4; ++j) { const int s = 16 * si + 4 * quad + j, t = 16 * ti + fr; const bool on = d == 0 ? (s <= t) : (s >= t);
                        const float wgt = on ? __expf(bt + a4[j]) : 0.f; p[4 * kk + j] = s4[j] * wgt; }
                }
                den1 += ((p[0] + p[1]) + (p[2] + p[3])) + ((p[4] + p[5]) + (p[6] + p[7]));
                const bf16x8 pf = pack8(p);
#pragma unroll
                for (int dvt = 0; dvt < 4; ++dvt) { const LAS unsigned char* vr = VT + (16 * dvt + fr) * VT_RS + (32 * g + 4 * quad) * 2;
                    const u32x2 lo = *(const LAS u32x2*)vr, hi = *(const LAS u32x2*)(vr + 32);
                    num1[dvt] = __builtin_amdgcn_mfma_f32_16x16x32_bf16(__builtin_bit_cast(bf16x8, (u32x4){lo.x, lo.y, hi.x, hi.y}), pf, num1[dvt], 0, 0, 0); }
            }
        }
        den1 += __shfl_xor(den1, 16); den1 += __shfl_xor(den1, 32);
        const float den = den1 + ebt * den2, inv = __builtin_amdgcn_rcpf(fmaxf(fabsf(den), 1.0f));
        f32x4 hs[4];
#pragma unroll
        for (int dvt = 0; dvt < 4; ++dvt) hs[dvt] = (num1[dvt] + num2[dvt] * ebt) * inv;
        if (d == 0) {
#pragma unroll
            for (int dvt = 0; dvt < 4; ++dvt) oscr[(ti * 4 + dvt) * 64 + F.lane] = hs[dvt];
        } else {
            float ss = 0.f;
#pragma unroll
            for (int dvt = 0; dvt < 4; ++dvt) { hs[dvt] = hs[dvt] + pk[dvt]; ss += (hs[dvt][0] * hs[dvt][0] + hs[dvt][1] * hs[dvt][1]) + (hs[dvt][2] * hs[dvt][2] + hs[dvt][3] * hs[dvt][3]); }
            ss += __shfl_xor(ss, 16); ss += __shfl_xor(ss, 32);
            const float rs = rsqrtf(ss * (1.0f / 64.0f) + EPS); const int row = row0 + 16 * ti + fr;
            bf16_t* mix = (bf16_t*)(F.ws + WS_MIX);
#pragma unroll
            for (int dvt = 0; dvt < 4; ++dvt) { const int ch = h * 64 + 16 * dvt + 4 * quad; const f32x4 w4 = nwv[dvt]; const u32x2 oz = ozv[dvt];
                u32x2 w; w.x = pg8::cvt_pk_bf16(hs[dvt][0] * rs * w4[0] * sigmoidf_(bflo(oz.x)), hs[dvt][1] * rs * w4[1] * sigmoidf_(bfhi(oz.x)));
                w.y = pg8::cvt_pk_bf16(hs[dvt][2] * rs * w4[2] * sigmoidf_(bflo(oz.y)), hs[dvt][3] * rs * w4[3] * sigmoidf_(bfhi(oz.y)));
                *(u32x2*)(mix + (size_t)row * D + 768 + ch) = w; }
        }
        qc[0] = qn[0]; qc[1] = qn[1];
    }
}
DI void mlstm_pass3(const Frame& F, int li, int task, int ti_lo = 0, int ti_hi = 4) {
    const int tc = task % 36, bh = task / 36, h = bh & 3, b = bh >> 2;
    const int row0 = chunk_row0(b, tc), fr = F.lane & 15, quad = F.lane >> 4;
    LAS unsigned char* L = F.lds + F.wave * ML3_LDS; LAS unsigned char* KI = L; LAS unsigned char* VT = L + 8192; LAS float* bb = (LAS float*)(VT + 64 * VT_RS); LAS float* ab = bb + 128; LAS float* n0 = ab + 128;
    { const bf16_t* zk = (const bf16_t*)(F.ws + WS_Z) + (size_t)(row0 + (F.lane >> 3)) * ZC + Z_MLK + h * 64 + (F.lane & 7) * 8;
      u32x4 kw[8];
#pragma unroll
      for (int i = 0; i < 8; ++i) kw[i] = *(const u32x4*)(zk + (size_t)(8 * i) * ZC);
#pragma unroll
      for (int i = 0; i < 8; ++i) { const int r = 8 * i + (F.lane >> 3); *(LAS u32x4*)(KI + r * 128 + (((F.lane & 7) ^ ((r >> 1) & 7)) * 16)) = kw[i]; } }
    const bf16_t* Z = (const bf16_t*)(F.ws + WS_Z);
    stage_t32<VT_RS>(Z + (size_t)row0 * ZC + Z_MLV + h * 64, VT, F.lane);
    stage_t32<VT_RS>(Z + (size_t)(row0 + 32) * ZC + Z_MLV + h * 64, VT + 64, F.lane);
#pragma unroll
    for (int d = 0; d < 2; ++d) {
        const size_t st = (size_t)(bh * 2 + d) * 36 + dir_chunk(d, tc);
        const float* zg = (const float*)(F.ws + WS_ZG) + (size_t)(row0 + F.lane) * 16; const float xa = zg[d * 4 + h], lf = logsigmoidf_(zg[8 + d * 4 + h]);
        const float bs = dir_scan(lf, d, F.lane); bb[64 * d + F.lane] = bs; ab[64 * d + F.lane] = xa - bs; n0[64 * d + F.lane] = ((const float*)(F.ws + WS_MLN))[st * 64 + F.lane];
    }
    f32x4* oscr = (f32x4*)(F.ws + WS_MLO) + (size_t)task * 16 * 64;
    mlstm_dir<0>(F, li, bh, tc, row0, fr, quad, KI, VT, bb, ab, n0, oscr, ti_lo, ti_hi);
    asm volatile("s_waitcnt vmcnt(0)" ::: "memory");
    mlstm_dir<1>(F, li, bh, tc, row0, fr, quad, KI, VT, bb, ab, n0, oscr, ti_lo, ti_hi);
}
DI float hg_forget(float lbv, unsigned short raw) { return lbv + (1.0f - lbv) * sigmoidf_(bf2f(raw)); }
template <int d> DI void hgrn2_pass1_dir(const Frame& F, int li, int task, int b, int h, int c) {
    const int row0 = chunk_row0(b, dir_chunk(d, c)), fr = F.lane & 15, quad = F.lane >> 4;
    LAS unsigned char* L = F.lds + F.wave * 16384; LAS unsigned char* KT = L; LAS unsigned char* VT = L + 64 * P1_RS;
    const bf16_t* zc = (const bf16_t*)(F.ws + WS_Z) + (size_t)row0 * ZC + h * 64;
    const float lbv = ((const float*)(F.ws + WS_LB))[(li * 2 + d) * 256 + h * 64 + F.lane];
    f32x4 acc[4][4];
#pragma unroll
    for (int i = 0; i < 4; ++i)
#pragma unroll
        for (int j = 0; j < 4; ++j) acc[i][j] = (f32x4){0.f, 0.f, 0.f, 0.f};
    float run = 1.0f;
#pragma unroll 1
    for (int hh = 0; hh < 2; ++hh) {
        const int half = d == 0 ? 1 - hh : hh;
        stage_t32<P1_RS>(zc + (size_t)(32 * half) * ZC + Z_HGF + d * 256, KT, F.lane);
        stage_t32<P1_RS>(zc + (size_t)(32 * half) * ZC + Z_HGI, VT, F.lane);
        { LAS unsigned char* kr = KT + F.lane * P1_RS;
          unsigned raw[16]; float kh[32];
#pragma unroll
          for (int q = 0; q < 8; ++q) { const u32x2 w = *(const LAS u32x2*)(kr + 8 * q); raw[2 * q] = w.x; raw[2 * q + 1] = w.y; }
#pragma unroll
          for (int it = 0; it < 32; ++it) { const int jj = d == 0 ? 31 - it : it; const unsigned short r = (unsigned short)((jj & 1) ? (raw[jj >> 1] >> 16) : (raw[jj >> 1] & 0xffffu));
              const float f = hg_forget(lbv, r); kh[jj] = (1.0f - f) * run; run *= f; }
#pragma unroll
          for (int q = 0; q < 8; ++q) { u32x2 w; w.x = pg8::cvt_pk_bf16(kh[4 * q], kh[4 * q + 1]); w.y = pg8::cvt_pk_bf16(kh[4 * q + 2], kh[4 * q + 3]); *(LAS u32x2*)(kr + 8 * q) = w; } }
        bf16x8 af[4], bfr[4];
#pragma unroll
        for (int i = 0; i < 4; ++i) { af[i] = lds_frag64(KT + (16 * i + fr) * P1_RS + quad * 16); bfr[i] = lds_frag64(VT + (16 * i + fr) * P1_RS + quad * 16); }
#pragma unroll
        for (int i = 0; i < 4; ++i)
#pragma unroll
            for (int j = 0; j < 4; ++j) acc[i][j] = __builtin_amdgcn_mfma_f32_16x16x32_bf16(af[i], bfr[j], acc[i][j], 0, 0, 0);
    }
    bf16_t* So = (bf16_t*)(F.ws + WS_SLOC_HG) + (size_t)task * 4096;
#pragma unroll
    for (int i = 0; i < 4; ++i)
#pragma unroll
        for (int j = 0; j < 4; ++j) { u32x2 w; w.x = pg8::cvt_pk_nv(acc[i][j][0], acc[i][j][1]); w.y = pg8::cvt_pk_nv(acc[i][j][2], acc[i][j][3]); *(u32x2*)(So + (16 * j + fr) * 64 + 16 * i + 4 * quad) = w; }
    ((float*)(F.ws + WS_HGP))[(size_t)task * 64 + F.lane] = run;
}
DI void hgrn2_pass1(const Frame& F, int li, int task) {
    const int c = task % 36, sq = task / 36, d = sq & 1, h = (sq >> 1) & 3, b = sq >> 3;
    if (d == 0) hgrn2_pass1_dir<0>(F, li, task, b, h, c); else hgrn2_pass1_dir<1>(F, li, task, b, h, c);
}
constexpr int HQ_RS = 144, HK_RS = 40;
DI void load_t16(const bf16_t* g, int lane, u32x4 (&w)[2]) { const bf16_t* src = g + (size_t)(lane >> 2) * ZC + (lane & 3) * 8; w[0] = *(const u32x4*)src; w[1] = *(const u32x4*)(src + 32); }
DI void store_t16(const u32x4 (&w)[2], LAS unsigned char* img, int lane) {
    LAS unsigned char* dst = img + (lane >> 2) * 2 + ((lane & 3) * 8) * HK_RS;
#pragma unroll
    for (int i = 0; i < 2; ++i) { const unsigned ww[4] = {w[i].x, w[i].y, w[i].z, w[i].w};
#pragma unroll
        for (int jj = 0; jj < 4; ++jj) { *(LAS unsigned short*)(dst + (32 * i + 2 * jj) * HK_RS) = (unsigned short)(ww[jj] & 0xffffu); *(LAS unsigned short*)(dst + (32 * i + 2 * jj + 1) * HK_RS) = (unsigned short)(ww[jj] >> 16); } }
}
template <int d> DI void hgrn2_pass3_dir(const Frame& F, int li, int bh, int tc, int row0, LAS unsigned char* L, f32x4* oscr) {
    const int h = bh & 3, fr = F.lane & 15, quad = F.lane >> 4;
    LAS unsigned char* Qt = L; LAS unsigned char* Kt = L + 16 * HQ_RS; LAS unsigned char* KhT = Kt + 16 * HQ_RS; LAS unsigned char* VTt = KhT + 64 * HK_RS; LAS unsigned char* QrT = VTt + 64 * HK_RS; LAS float* eBb = (LAS float*)(QrT + 64 * HK_RS);
    const bf16_t* zc = (const bf16_t*)(F.ws + WS_Z) + (size_t)row0 * ZC + h * 64;
    const float lbv = ((const float*)(F.ws + WS_LB))[(li * 2 + d) * 256 + h * 64 + F.lane];
    const size_t st = (size_t)(bh * 2 + d) * 36 + dir_chunk(d, tc);
    const bf16_t* S0 = (const bf16_t*)(F.ws + WS_SBF_HG) + st * 4096;
    f32x4 S[4][4];
#pragma unroll
    for (int i = 0; i < 4; ++i)
#pragma unroll
        for (int jt = 0; jt < 4; ++jt) { const u32x2 w = *(const u32x2*)(S0 + (16 * jt + fr) * 64 + 16 * i + 4 * quad); S[i][jt] = (f32x4){bflo(w.x), bfhi(w.x), bflo(w.y), bfhi(w.y)}; }
    u32x4 nf[2], nq[2], nv[2];
    f32x4 nwv[4];
    if (d == 1) {
#pragma unroll
        for (int dvt = 0; dvt < 4; ++dvt) nwv[dvt] = *(const f32x4*)(F.in[I_HGNW] + li * 256 + h * 64 + 16 * dvt + 4 * quad); }
    { const bf16_t* zn = zc + (size_t)(16 * (d == 0 ? 0 : 3)) * ZC; load_t16(zn + Z_HGF + d * 256, F.lane, nf); load_t16(zn + Z_HGQ, F.lane, nq); load_t16(zn + Z_HGI, F.lane, nv); }
#pragma unroll 1
    for (int uu = 0; uu < 4; ++uu) {
        const int u = d == 0 ? uu : 3 - uu, t0 = 16 * u;
        store_t16(nf, KhT, F.lane); store_t16(nq, QrT, F.lane); store_t16(nv, VTt, F.lane);
        if (uu < 3) { const bf16_t* zn = zc + (size_t)(16 * (d == 0 ? uu + 1 : 2 - uu)) * ZC; load_t16(zn + Z_HGF + d * 256, F.lane, nf); load_t16(zn + Z_HGQ, F.lane, nq); load_t16(zn + Z_HGI, F.lane, nv); }
        f32x4 pk[4]; u32x2 gzv[4];
        if (d == 1) { const bf16_t* zg_ = (const bf16_t*)(F.ws + WS_Z) + (size_t)(row0 + 16 * u + fr) * ZC + Z_HGG + h * 64 + 4 * quad;
#pragma unroll
            for (int dvt = 0; dvt < 4; ++dvt) { pk[dvt] = oscr[(u * 4 + dvt) * 64 + F.lane]; gzv[dvt] = *(const u32x2*)(zg_ + 16 * dvt); }
            __builtin_amdgcn_sched_barrier(0); }
        { float kt[16]; float run = 1.0f; unsigned rf[8], rq[8];
          { LAS unsigned char* fr_ = KhT + F.lane * HK_RS; LAS unsigned char* qr_ = QrT + F.lane * HK_RS;
#pragma unroll
            for (int q = 0; q < 4; ++q) { const u32x2 a = *(const LAS u32x2*)(fr_ + 8 * q), c2 = *(const LAS u32x2*)(qr_ + 8 * q); rf[2 * q] = a.x; rf[2 * q + 1] = a.y; rq[2 * q] = c2.x; rq[2 * q + 1] = c2.y; } }
#pragma unroll
          for (int it = 0; it < 16; ++it) {
              const int t = d == 0 ? it : 15 - it;
              const unsigned short rawf = (unsigned short)((t & 1) ? (rf[t >> 1] >> 16) : (rf[t >> 1] & 0xffffu)), rawq = (unsigned short)((t & 1) ? (rq[t >> 1] >> 16) : (rq[t >> 1] & 0xffffu));
              const float f = hg_forget(lbv, rawf);
              run = fmaxf(run * f, 1e-30f);
              *(LAS unsigned short*)(Qt + t * HQ_RS + F.lane * 2) = (unsigned short)(pg8::cvt_pk_nv(bf2f(rawq) * run, 0.f) & 0xffffu);
              kt[t] = (1.0f - f) * __builtin_amdgcn_rcpf(run);
              *(LAS unsigned short*)(Kt + t * HQ_RS + F.lane * 2) = (unsigned short)(pg8::cvt_pk_nv(kt[t], 0.f) & 0xffffu);
          }
          eBb[F.lane] = run;
#pragma unroll
          for (int q = 0; q < 4; ++q) { u32x2 w; w.x = pg8::cvt_pk_bf16(kt[4 * q] * run, kt[4 * q + 1] * run); w.y = pg8::cvt_pk_bf16(kt[4 * q + 2] * run, kt[4 * q + 3] * run); *(LAS u32x2*)(KhT + F.lane * HK_RS + 8 * q) = w; } }
        f32x4 at4 = (f32x4){0.f, 0.f, 0.f, 0.f};
#pragma unroll
        for (int ks = 0; ks < 2; ++ks) at4 = __builtin_amdgcn_mfma_f32_16x16x32_bf16(*(const LAS bf16x8*)(Kt + fr * HQ_RS + (32 * ks + 8 * quad) * 2), *(const LAS bf16x8*)(Qt + fr * HQ_RS + (32 * ks + 8 * quad) * 2), at4, 0, 0, 0);
        float p[8];
#pragma unroll
        for (int j = 0; j < 4; ++j) { const int s = 4 * quad + j; p[j] = (d == 0 ? (s <= fr) : (s >= fr)) ? at4[j] : 0.f; p[4 + j] = 0.f; }
        const bf16x8 pf = pack8(p);
        bf16x8 qp[2];
#pragma unroll
        for (int g = 0; g < 2; ++g) { const u32x2 lo = *(const LAS u32x2*)(Qt + fr * HQ_RS + (32 * g + 4 * quad) * 2), hi = *(const LAS u32x2*)(Qt + fr * HQ_RS + (32 * g + 16 + 4 * quad) * 2); qp[g] = __builtin_bit_cast(bf16x8, (u32x4){lo.x, lo.y, hi.x, hi.y}); }
        f32x4 o4s[4];
#pragma unroll
        for (int dvt = 0; dvt < 4; ++dvt) {
            const u32x2 vlo = *(const LAS u32x2*)(VTt + (16 * dvt + fr) * HK_RS + (4 * quad) * 2);
            f32x4 o4 = __builtin_amdgcn_mfma_f32_16x16x32_bf16(__builtin_bit_cast(bf16x8, (u32x4){vlo.x, vlo.y, 0u, 0u}), pf, (f32x4){0.f, 0.f, 0.f, 0.f}, 0, 0, 0);
#pragma unroll
            for (int g = 0; g < 2; ++g) { const float sp[8] = {S[2 * g][dvt][0], S[2 * g][dvt][1], S[2 * g][dvt][2], S[2 * g][dvt][3], S[2 * g + 1][dvt][0], S[2 * g + 1][dvt][1], S[2 * g + 1][dvt][2], S[2 * g + 1][dvt][3]};
                o4 = __builtin_amdgcn_mfma_f32_16x16x32_bf16(pack8(sp), qp[g], o4, 0, 0, 0); }
            o4s[dvt] = o4;
        }
        if (d == 0) {
#pragma unroll
            for (int dvt = 0; dvt < 4; ++dvt) oscr[(u * 4 + dvt) * 64 + F.lane] = o4s[dvt];
        } else {
            float ss = 0.f;
#pragma unroll
            for (int dvt = 0; dvt < 4; ++dvt) { o4s[dvt] = o4s[dvt] + pk[dvt]; ss += (o4s[dvt][0] * o4s[dvt][0] + o4s[dvt][1] * o4s[dvt][1]) + (o4s[dvt][2] * o4s[dvt][2] + o4s[dvt][3] * o4s[dvt][3]); }
            ss += __shfl_xor(ss, 16); ss += __shfl_xor(ss, 32);
            const float rs = rsqrtf(ss * (1.0f / 64.0f) + EPS); const int row = row0 + 16 * u + fr;
            bf16_t* mix = (bf16_t*)(F.ws + WS_MIX);
#pragma unroll
            for (int dvt = 0; dvt < 4; ++dvt) { const int ch = h * 64 + 16 * dvt + 4 * quad; const f32x4 w4 = nwv[dvt]; const u32x2 gz = gzv[dvt];
                u32x2 w; w.x = pg8::cvt_pk_bf16(o4s[dvt][0] * rs * w4[0] * siluf_(bflo(gz.x)), o4s[dvt][1] * rs * w4[1] * siluf_(bfhi(gz.x)));
                w.y = pg8::cvt_pk_bf16(o4s[dvt][2] * rs * w4[2] * siluf_(bflo(gz.y)), o4s[dvt][3] * rs * w4[3] * siluf_(bfhi(gz.y)));
                *(u32x2*)(mix + (size_t)row * D + ch) = w; }
        }
        bf16x8 af[4], bfr[4];
#pragma unroll
        for (int i = 0; i < 4; ++i) {
            const u32x4 a = __builtin_bit_cast(u32x4, lds_frag64(KhT + (16 * i + fr) * HK_RS + (quad & 1) * 16)), v = __builtin_bit_cast(u32x4, lds_frag64(VTt + (16 * i + fr) * HK_RS + (quad & 1) * 16));
            af[i] = __builtin_bit_cast(bf16x8, quad < 2 ? a : (u32x4){0u, 0u, 0u, 0u}); bfr[i] = __builtin_bit_cast(bf16x8, quad < 2 ? v : (u32x4){0u, 0u, 0u, 0u});
        }
#pragma unroll
        for (int i = 0; i < 4; ++i) { const f32x4 e4 = *(const LAS f32x4*)(eBb + 16 * i + 4 * quad);
#pragma unroll
            for (int jt = 0; jt < 4; ++jt) S[i][jt] = __builtin_amdgcn_mfma_f32_16x16x32_bf16(af[i], bfr[jt], S[i][jt] * e4, 0, 0, 0); }
    }
}
constexpr size_t WS_HGO = WS_T0;
DI void hgrn2_pass3(const Frame& F, int li, int task) {
    const int tc = task % 36, bh = task / 36, b = bh >> 2;
    const int row0 = chunk_row0(b, tc);
    LAS unsigned char* L = F.lds + F.wave * ML3_LDS;
    f32x4* oscr = (f32x4*)(F.ws + WS_HGO) + (size_t)task * 16 * 64;
    hgrn2_pass3_dir<0>(F, li, bh, tc, row0, L, oscr);
    asm volatile("s_waitcnt vmcnt(0)" ::: "memory");
    hgrn2_pass3_dir<1>(F, li, bh, tc, row0, L, oscr);
}
DI void select_task(const Frame& F, int task, int MT) {
    const int s = task >> 4, e = task & 15, n = s < 16 ? NL : NC, cap = n >> 3;
    LAS int* wsum = (LAS int*)F.lds;
    const float* aff = (const float*)(F.ws + WS_AFF) + ((size_t)s * 16 + e) * 2048;
    unsigned a[4];
    { const int i0 = 4 * F.tid; if (i0 < n) { const u32x4 w = *(const u32x4*)((const unsigned*)aff + i0); a[0] = w.x; a[1] = w.y; a[2] = w.z; a[3] = w.w; } else { a[0] = a[1] = a[2] = a[3] = 0u; } }
    __syncthreads();
    unsigned lo = 0u, hi = 0x7f800001u; int it = 0;
    while (hi - lo > 1u) {
        const unsigned mid = lo + ((hi - lo) >> 1);
        int c = 0;
#pragma unroll
        for (int j = 0; j < 4; ++j) c += __builtin_popcountll(__ballot(a[j] >= mid));
        LAS int* wb = wsum + (it & 1) * 8; if (F.lane == 0) wb[F.wave] = c;
        __syncthreads();
        int tot = 0;
#pragma unroll
        for (int w = 0; w < 8; ++w) tot += wb[w];
        if (tot >= cap) lo = mid; else hi = mid;
        ++it;
    }
    const unsigned thr = lo;
    LAS int* sc = wsum + 16;
    int ceq = 0, cgt = 0;
#pragma unroll
    for (int j = 0; j < 4; ++j) { ceq += a[j] == thr; cgt += a[j] > thr; }
    __syncthreads();
    { int c = cgt;
#pragma unroll
      for (int o = 1; o < 64; o <<= 1) c += __shfl_xor(c, o);
      if (F.lane == 0) sc[F.wave] = c; }
    __syncthreads();
    int totgt = 0;
#pragma unroll
    for (int w = 0; w < 8; ++w) totgt += sc[w];
    const int need_eq = cap - totgt;
    __syncthreads();
    int pre = ceq;
#pragma unroll
    for (int o = 1; o < 64; o <<= 1) { const int t = __shfl_up(pre, o); if (F.lane >= o) pre += t; }
    if (F.lane == 63) sc[F.wave] = pre;
    __syncthreads();
    int base = 0;
    for (int w = 0; w < F.wave; ++w) base += sc[w];
    int eqbefore = base + pre - ceq;
    bool sel[4]; int csel = 0;
#pragma unroll
    for (int j = 0; j < 4; ++j) { const bool iseq = a[j] == thr; sel[j] = (a[j] > thr) || (iseq && eqbefore < need_eq); eqbefore += iseq; csel += sel[j]; }
    __syncthreads();
    pre = csel;
#pragma unroll
    for (int o = 1; o < 64; o <<= 1) { const int t = __shfl_up(pre, o); if (F.lane >= o) pre += t; }
    if (F.lane == 63) sc[F.wave] = pre;
    __syncthreads();
    base = 0;
    for (int w = 0; w < F.wave; ++w) base += sc[w];
    int rank = base + pre - csel;
    int* inv = (int*)(F.ws + WS_INV) + ((size_t)s * 16 + e) * 2048; float* gate = (float*)(F.ws + WS_GATE); int* rsrc = (int*)(F.ws + WS_RSRC);
    if (4 * F.tid < n) {
#pragma unroll
        for (int j = 0; j < 4; ++j) { const int t = 4 * F.tid + j;
            if (sel[j]) { const int xr = xs_row(e, s, rank, MT); gate[xr] = __builtin_bit_cast(float, a[j]); rsrc[xr] = s < 16 ? s * NL + t : NLAT + (s - 16) * NC + t; inv[t] = rank; ++rank; } else inv[t] = -1; }
    }
    __syncthreads();
    __syncthreads();
}

#define XB_TMO      128
#define XB_XCNT(j)  (256  + 64 * (j))
#define XB_XSUB(j)  (1280 + 64 * (j))
#define XB_XGEN(j)  (2304 + 64 * (j))
#define XB_TOP      3328
#define XB_TOPGEN   3392
#define XCD_BAR_WORDS 3456
#define XB_SPIN_CAP (1u << 18)

__device__ __forceinline__ unsigned xb_ld(unsigned* p)              { return __hip_atomic_load(p, __ATOMIC_RELAXED, __HIP_MEMORY_SCOPE_AGENT); }
__device__ __forceinline__ unsigned xb_add(unsigned* p, unsigned v) { return __hip_atomic_fetch_add(p, v, __ATOMIC_RELAXED, __HIP_MEMORY_SCOPE_AGENT); }
__device__ __forceinline__ unsigned xb_xcc_id() { return (unsigned)__builtin_amdgcn_s_getreg((3 << 11) | 20) & 0xFu; }
#define XB_SPIN(cond, bar) do { unsigned _sp = 0; while (cond) { __builtin_amdgcn_s_sleep(1); \
    if ((++_sp & 255u) == 0u) { if (xb_ld(&(bar)[XB_TMO])) break; if (_sp > XB_SPIN_CAP) { atomicAdd(&(bar)[XB_TMO], 1u); break; } } } } while (0)

struct XcdBarrier {
    unsigned* bar; unsigned x;
    volatile LAS unsigned* st;
};

__device__ __forceinline__ XcdBarrier xcd_barrier_post(unsigned* bar, volatile LAS unsigned* st) {
    XcdBarrier b; b.bar = bar; b.x = xb_xcc_id(); b.st = st;
    if (threadIdx.x == 0) (void)xb_add(&bar[XB_XCNT(b.x)], 1u);
    return b;
}
__device__ __forceinline__ void xcd_barrier_complete(unsigned* bar, unsigned x, unsigned& nloc, unsigned& nx) {
    const unsigned G = gridDim.x * gridDim.y * gridDim.z;
    unsigned sum, cnt, mine, sp = 0u;
    for (;;) {
        sum = 0u; cnt = 0u; mine = 0u;
#pragma unroll
        for (unsigned j = 0; j < 16; ++j) { const unsigned c = xb_ld(&bar[XB_XCNT(j)]); sum += c; cnt += (c > 0u) ? 1u : 0u; mine = (j == x) ? c : mine; }
        if (sum == G) break;
        __builtin_amdgcn_s_sleep(1);
        if ((++sp & 255u) == 0u) { if (xb_ld(&bar[XB_TMO])) break; if (sp > XB_SPIN_CAP) { atomicAdd(&bar[XB_TMO], 1u); break; } }
    }
    nloc = mine > 0u ? mine : 1u; nx = cnt > 0u ? cnt : 1u;
}

__device__ __forceinline__ void xcd_barrier(const XcdBarrier& b) {
    asm volatile("s_waitcnt vmcnt(0)" ::: "memory");
    __syncthreads();
    if (threadIdx.x == 0) {
        unsigned* bar = b.bar;
        __builtin_amdgcn_s_waitcnt(0);
        unsigned nloc = b.st[0], nx = b.st[1];
        if (nloc == 0u) { xcd_barrier_complete(bar, b.x, nloc, nx); b.st[0] = nloc; b.st[1] = nx; }
        const unsigned old = xb_add(&bar[XB_XSUB(b.x)], 1u);
        const unsigned gen = old / nloc;
        if (old + 1u == (gen + 1u) * nloc) {
            __builtin_amdgcn_fence(__ATOMIC_RELEASE, "agent");
            asm volatile("s_waitcnt vmcnt(0)" ::: "memory");
            const unsigned og = xb_add(&bar[XB_TOP], 1u);
            const unsigned tg = og / nx;
            if (og + 1u == (tg + 1u) * nx) xb_add(&bar[XB_TOPGEN], 1u);
            else XB_SPIN(xb_ld(&bar[XB_TOPGEN]) == tg, bar);
            __builtin_amdgcn_fence(__ATOMIC_ACQUIRE, "agent");
            xb_add(&bar[XB_XGEN(b.x)], 1u);
            asm volatile("s_waitcnt vmcnt(0)" ::: "memory");
        } else {
            XB_SPIN(xb_ld(&bar[XB_XGEN(b.x)]) == gen, bar);
            __builtin_amdgcn_fence(__ATOMIC_ACQUIRE, "agent");
            asm volatile("s_waitcnt vmcnt(0)" ::: "memory");
        }
    }
    __syncthreads();
}
struct Args { const float* in[N_IN]; float* out; unsigned char* ws; int ph_lo, ph_hi; };
constexpr int PH_PER_LAYER = 11, PH_FINAL = 1 + DEPTH * PH_PER_LAYER, N_PHASES = PH_FINAL + 1;
#ifndef MK_N_LAUNCHES
#define MK_N_LAUNCHES 1
#endif
DI int fetch_task(unsigned* ctr, int lane) { int t = 0; if (lane == 0) t = (int)__hip_atomic_fetch_add(ctr, 1u, __ATOMIC_RELAXED, __HIP_MEMORY_SCOPE_AGENT); return __builtin_amdgcn_readfirstlane(t); }
#define TASK_LOOP(ctrword, N, call) do { unsigned* _c = (unsigned*)(F.ws + WS_CTL) + (ctrword); int _nx = fetch_task(_c, F.lane); while (_nx < (N)) { const int t = _nx; _nx = fetch_task(_c, F.lane); call; } } while (0)
constexpr int N_TAIL_IN = 8448, N_TAIL_OUT = 9216;
constexpr int N_PRECONV = 12288;
constexpr int CW_Q = 16384;
template <int li> DI void layer_body(const Frame& F, const XcdBarrier& bar, const int lo, const int hi) {
#define IN(k) (lo <= (k) && (k) < hi)
#define SEAM(k) do { if (IN((k) + 1)) xcd_barrier(bar); } while (0)

        const int pb = 1 + li * PH_PER_LAYER, MT = li == 0 ? 18 : 16;
        if (IN(pb + 0)) {
            const int cit0 = li > 0 ? phase_norm<0, true>(F, li, N_PRECONV) : (phase_norm<0>(F, li), 0);
            if (li > 0) { __syncthreads(); LAS float* scr = (LAS float*)(F.lds + 65536) + F.wave * (64 * 33);
                for (int it = cit0; it < NE * IT_EXP; it += F.G * NWAVES) { const int r = it % IT_EXP; if (F.G == 256 && r < 2048 && (it / IT_EXP) * 2048 + r < N_PRECONV) continue; expert_weight_item(F, li, it, scr); } }
            SEAM(pb + 0);
        }
        if (IN(pb + 1)) {
            __syncthreads();
            EpiInProj E{(bf16_t*)(F.ws + WS_Z), F.in[I_BIN] + li * INC, (const float*)(F.ws + WS_ROPE), (bf16_t*)(F.ws + WS_ACAT)};
            if (li < DEPTH - 1) { pg8::DenseOrder S; S.init(NTOK, ZC, F.G, F.bid, F.ws + WS_XN, D, F.ws + WS_WIN + (size_t)li * ZC * D * 2, D);
                pg8::gemm_phase<EpiInProj, pg8::DenseOrder, true, true>(F.lds, pg8::GemmDesc{D, D, D}, S, E);
}
            else { pg8::InProjLastOrder S; S.lat.init(NLAT, ZC, F.G, F.bid, F.ws + WS_XN, D, F.ws + WS_WIN + (size_t)li * ZC * D * 2, D); S.G = F.G; S.c = F.bid;
                pg8::gemm_phase<EpiInProj, pg8::InProjLastOrder, true, true>(F.lds, pg8::GemmDesc{D, D, D}, S, E); }
            SEAM(pb + 1);
        }
        if (IN(pb + 2)) {
            __syncthreads();
            { S5Order S{F.G, F.bid, (const char*)(F.ws + WS_ACAT), (const char*)(F.ws + WS_S5A) + (size_t)li * 16 * 256 * 256 * 2, (size_t)NCHK * 512 * 2, (size_t)256 * 256 * 2, (size_t)256 * 512 * 2};
              EpiS5A E{(bf16_t*)(F.ws + WS_XLOC)};
              pg8::gemm_phase<EpiS5A, S5Order, true, true>(F.lds, pg8::GemmDesc{256, 512, 256}, S, E);
            }
            __syncthreads();
            if (F.G == 256) {
                const int gw = F.bid * NWAVES + F.wave, x = gw - 144 * NWAVES;
                mlstm_pass1(F, gw); mlstm_pass1(F, gw + 2048); if (x >= 0 && x < 512) mlstm_pass1(F, 4096 + x);
                hgrn2_pass1(F, li, gw); hgrn2_pass1(F, li, gw + 2048); if (x >= 384) hgrn2_pass1(F, li, 4096 + (x - 384));
            } else {
            for (int t = F.bid * NWAVES + F.wave; t < 128 * 36; t += F.G * NWAVES) mlstm_pass1(F, t);
            for (int t = F.G * NWAVES - 1 - (F.bid * NWAVES + F.wave); t < 128 * 36; t += F.G * NWAVES) hgrn2_pass1(F, li, t);
            }
            SEAM(pb + 2);
        }
        if (IN(pb + 3)) {
            __syncthreads();
            if (F.tid < 128) for (int i = F.bid * 128 + F.tid; i < 16 * 16 * 2 * 64; i += F.G * 128) s5_carry_item(F, li, i);
            for (int i = F.bid * NTHR + F.tid; i < 128 * 1024; i += F.G * NTHR) carry_item<false>((const bf16_t*)(F.ws + WS_SLOC_ML), (const float*)(F.ws + WS_MLP), (bf16_t*)(F.ws + WS_SBF_ML), i);
            if (F.G == 256) {
                if (F.tid >= 128) carry_item<true>((const bf16_t*)(F.ws + WS_SLOC_HG), (const float*)(F.ws + WS_HGP), (bf16_t*)(F.ws + WS_SBF_HG), F.bid * NTHR + F.tid);
                if (F.tid >= 128 && F.tid < 256) carry_item<true>((const bf16_t*)(F.ws + WS_SLOC_HG), (const float*)(F.ws + WS_HGP), (bf16_t*)(F.ws + WS_SBF_HG), F.bid * NTHR + F.tid - 128);
            } else
            for (int i = F.bid * NTHR + F.tid; i < 128 * 1024; i += F.G * NTHR) carry_item<true>((const bf16_t*)(F.ws + WS_SLOC_HG), (const float*)(F.ws + WS_HGP), (bf16_t*)(F.ws + WS_SBF_HG), i);
            { const int per = (128 * 64 + F.G - 1) / F.G, t0 = NTHR - per;
              if (per <= NTHR) { if (F.tid >= t0) { const int i = F.bid * per + (F.tid - t0); if (i < 128 * 64) carry_n_item((float*)(F.ws + WS_MLN), (const float*)(F.ws + WS_MLP), i); } }
              else for (int i = F.bid * NTHR + F.tid; i < 128 * 64; i += F.G * NTHR) carry_n_item((float*)(F.ws + WS_MLN), (const float*)(F.ws + WS_MLP), i); }
            { float lam_init; const float lam = da_lambda(F, li, lam_init); const int nat = li == 0 ? 512 + 64 : 512;
              for (int t = F.bid; t < nat; t += F.G) attn_unit(F, li, t, lam, lam_init);
            }
            SEAM(pb + 3);
        }
        if (IN(pb + 4)) {
            __syncthreads();
            const bool l1deal = li == DEPTH - 1 && F.G == 256;
            { S5Order S{F.G, F.bid, (const char*)(F.ws + WS_ACAT), (const char*)(F.ws + WS_S5B) + (size_t)li * 16 * 256 * 512 * 2, (size_t)NCHK * 512 * 2, (size_t)256 * 512 * 2, (size_t)256 * 512 * 2, l1deal ? 8 : 9, l1deal ? 128 : 144};
              EpiS5B E{(const bf16_t*)(F.ws + WS_ACAT), F.in[I_S5D] + li * 256, (bf16_t*)(F.ws + WS_MIX)};
              pg8::gemm_phase<EpiS5B, S5Order, true, true>(F.lds, pg8::GemmDesc{512, 512, 512}, S, E);
            }
            __syncthreads();
            if (F.G == 256 && li == 0) {
                const int gw = F.bid * NWAVES + F.wave, x = gw - 144 * NWAVES;
                mlstm_pass3(F, li, gw); if (x >= 0 && x < 256) mlstm_pass3(F, li, 2048 + x);
                hgrn2_pass3(F, li, gw); if (x >= 256 && x < 512) hgrn2_pass3(F, li, 2048 + (x - 256));
            } else if (l1deal) {
                const int gw = F.bid * NWAVES + F.wave;
                if (F.bid >= 128) { const int t0 = gw - 1024; mlstm_pass3(F, li, (t0 >> 5) * 36 + 4 + (t0 & 31)); mlstm_pass3(F, li, (gw >> 5) * 36 + 4 + (gw & 31)); }
                hgrn2_pass3(F, li, (gw >> 5) * 36 + 4 + (gw & 31));
            } else {
            for (int t = F.bid * NWAVES + F.wave; t < 64 * (li == 0 ? 36 : 32); t += F.G * NWAVES) mlstm_pass3(F, li, li == 0 ? t : (t >> 5) * 36 + 4 + (t & 31));
            for (int t = F.G * NWAVES - 1 - (F.bid * NWAVES + F.wave); t < 64 * (li == 0 ? 36 : 32); t += F.G * NWAVES) hgrn2_pass3(F, li, li == 0 ? t : (t >> 5) * 36 + 4 + (t & 31));
            }
            SEAM(pb + 4);
        }
        if (IN(pb + 5)) {
            __syncthreads();
            { pg8::DenseOrder S; S.init(li == 0 ? NTOK : NLAT, 256, F.G, F.bid, F.ws + WS_MIX + 512, D, F.ws + WS_GLUW + (size_t)li * 256 * 256 * 2, 256);
              EpiGLU E{(bf16_t*)(F.ws + WS_MIX), F.in[I_S5GB] + li * 256};
              pg8::gemm_phase<EpiGLU, pg8::DenseOrder, true, true>(F.lds, pg8::GemmDesc{256, D, 256}, S, E); }

            SEAM(pb + 5);
        }
        if (IN(pb + 6)) {
            __syncthreads();
            pg8::DenseOrder S; S.init(li == 0 ? NTOK : NLAT, D, F.G, F.bid, F.ws + WS_MIX, D, F.ws + WS_WOUT + (size_t)li * D * D * 2, D);
            EpiOutProj E{F.in[I_X], F.in[I_CTX], li == 0 ? nullptr : (const bf16_t*)(F.ws + WS_HL), (bf16_t*)(F.ws + WS_HL), (const float*)(F.ws + WS_MOD) + (size_t)li * 17 * 6144 + 2 * 1024};
            pg8::gemm_phase<EpiOutProj, pg8::DenseOrder, true, true>(F.lds, pg8::GemmDesc{D, D, D}, S, E);

            SEAM(pb + 6);
        }
        if (IN(pb + 7)) { __syncthreads(); phase_norm<1>(F, li); SEAM(pb + 7); }
        if (IN(pb + 8)) { __syncthreads(); const int nt = li == 0 ? 512 : 256; for (int t = F.bid; t < nt; t += F.G) select_task(F, t, MT); SEAM(pb + 8); }
        if (IN(pb + 9)) {
            __syncthreads();
            pg8::MoeOrder<true> S{(const int*)(F.ws + WS_RSRC), MT, 16, F.G, F.bid, (const char*)(F.ws + WS_XN), (const char*)(F.ws + WS_W13), (size_t)256 * D * 2, (size_t)MT * 256 * D * 2, (size_t)256 * D * 2, (size_t)4096 * D * 2};
            EpiSwiGLU E{(bf16_t*)(F.ws + WS_H), MT};
            pg8::gemm_phase<EpiSwiGLU, pg8::MoeOrder<true>, true, true>(F.lds, pg8::GemmDesc{D, D, D}, S, E);
            SEAM(pb + 9);
        }
        if (IN(pb + 10)) {
            __syncthreads();
            pg8::MoeOrder<false> S{nullptr, MT, 4, F.G, F.bid, (const char*)(F.ws + WS_H), (const char*)(F.ws + WS_W2), (size_t)256 * DE * 2, (size_t)MT * 256 * DE * 2, (size_t)256 * DE * 2, (size_t)D * DE * 2};
            EpiDown E{(bf16_t*)(F.ws + WS_XS), (const float*)(F.ws + WS_GATE), MT};
            pg8::gemm_phase<EpiDown, pg8::MoeOrder<false>, true, true>(F.lds, pg8::GemmDesc{DE, DE, DE}, S, E);
            if (li < DEPTH - 1 && F.G == 256 && (F.bid >> 3) >= 16) {
                __syncthreads(); LAS float* scr = (LAS float*)F.lds + F.wave * (64 * 33);
                for (int j = (((F.bid >> 3) - 16) * 8 + (F.bid & 7)) * NWAVES + F.wave; j < N_PRECONV; j += 128 * NWAVES) expert_weight_item(F, li + 1, (j >> 11) * IT_EXP + (j & 2047), scr);
            }
            SEAM(pb + 10);
        }

#undef IN
#undef SEAM
}
__global__ void __launch_bounds__(NTHR, 2) fwd_kernel(Args args) {
    extern __shared__ __attribute__((aligned(16))) unsigned char lds_raw[];
    Frame F; F.lds = (LAS unsigned char*)lds_raw; F.ws = args.ws; F.in = args.in; F.out = args.out;
    F.tid = threadIdx.x; F.lane = F.tid & 63; F.wave = __builtin_amdgcn_readfirstlane(F.tid >> 6); F.bid = blockIdx.x; F.G = gridDim.x;
    volatile LAS unsigned* MISC = (volatile LAS unsigned*)(F.lds + MISC_OFF);
    if (F.tid < 32) MISC[F.tid] = 0u;
    __syncthreads();
    XcdBarrier bar = xcd_barrier_post((unsigned*)(F.ws + WS_CTL) + CW_BAR, MISC + 8);
    const int lo = args.ph_lo, hi = args.ph_hi;
#define IN(k) (lo <= (k) && (k) < hi)
#define SEAM(k) do { if (IN((k) + 1)) xcd_barrier(bar); } while (0)
    if (IN(0)) { phase_prologue(F);
      SEAM(0); }
    layer_body<0>(F, bar, lo, hi);
    layer_body<1>(F, bar, lo, hi);
    if (IN(PH_FINAL)) { __syncthreads(); phase_norm<2>(F, DEPTH - 1);
    }
#undef IN
#undef SEAM
}

extern "C" void kernel_launch(void* const* d_in, const int* in_sizes, int n_in, void* d_out, int out_size, void* d_ws, size_t ws_size, hipStream_t stream) {
    static int grid = 0;
    if (grid == 0) {
        if (n_in != N_IN || out_size != NLAT * D || ws_size < WS_END) { fprintf(stderr, "kernel_launch: unexpected shapes (n_in %d, out %d, ws %zu < %zu)\n", n_in, out_size, ws_size, (size_t)WS_END); grid = -1; return; }
        int dev = 0, cus = 0, per_cu = 0;
        if (hipGetDevice(&dev) != hipSuccess || hipDeviceGetAttribute(&cus, hipDeviceAttributeMultiprocessorCount, dev) != hipSuccess) { grid = -1; return; }
        if (hipFuncSetAttribute((const void*)fwd_kernel, hipFuncAttributeMaxDynamicSharedMemorySize, LDS_BYTES) != hipSuccess) { fprintf(stderr, "kernel_launch: hipFuncSetAttribute failed\n"); grid = -1; return; }
        if (hipOccupancyMaxActiveBlocksPerMultiprocessor(&per_cu, (const void*)fwd_kernel, NTHR, LDS_BYTES) != hipSuccess || per_cu < 1) fprintf(stderr, "kernel_launch: occupancy query says %d\n", per_cu);
        (void)hipGetLastError();
        grid = cus;
    }
    if (grid < 0) return;
    (void)hipMemsetAsync((char*)d_ws + WS_CTL, 0, CTL_BYTES, stream);
    Args a{};
    for (int i = 0; i < N_IN; ++i) a.in[i] = (const float*)d_in[i];
    a.out = (float*)d_out; a.ws = (unsigned char*)d_ws;
    const int nl = MK_N_LAUNCHES;
    for (int l = 0; l < nl; ++l) {
        a.ph_lo = (int)((long)l * N_PHASES / nl); a.ph_hi = (int)((long)(l + 1) * N_PHASES / nl);
        hipLaunchKernelGGL(fwd_kernel, dim3(grid), dim3(NTHR), LDS_BYTES, stream, a);
    }
}
```
